# Optimizing an MI355X kernel written in HIP

```python
import math
import jax, jax.numpy as jnp
from jax import lax
import numpy as np

D_MODEL = 1024
BATCH = 32
SEQ = 2048
DEPTH = 4

N_A = DEPTH // 2
N_B = DEPTH - N_A
HG_HEAD_DIM = 128
HG_HEADS = D_MODEL // HG_HEAD_DIM
HG_CHUNK = 32
MLA_HEADS = 16
Q_RANK = 256
KV_RANK = 128
NOPE_DIM = 128
ROPE_DIM = 64
V_DIM = 128
ROPE_THETA = 10000.0
Q_BLOCK = 128
N_EXPERTS = 32
TOP_K = 4
D_EXPERT = D_MODEL
SWIGLU_ALPHA = 1.702
SWIGLU_LIMIT = 7.0
EXPERT_BLOCK = 256
DN_ALPHA = (2.0 * DEPTH) ** 0.25
DN_BETA = (8.0 * DEPTH) ** -0.25
LN_EPS = 1e-5
RMS_EPS = 1e-6

kernel_name = 'yoco_hgrn2_mla_moe_deepnorm'

F32 = jnp.float32


def layer_norm(x, g, b):
    xf = x.astype(F32)
    mu = jnp.mean(xf, axis=-1, keepdims=True)
    var = jnp.mean(jnp.square(xf - mu), axis=-1, keepdims=True)
    y = (xf - mu) * lax.rsqrt(var + LN_EPS) * g.astype(F32) + b.astype(F32)
    return y.astype(x.dtype)


def rms_norm(x, g):
    xf = x.astype(F32)
    y = xf * lax.rsqrt(jnp.mean(jnp.square(xf), axis=-1, keepdims=True) + RMS_EPS) * g.astype(F32)
    return y.astype(x.dtype)


def rope_tables(positions):
    inv_freq = ROPE_THETA ** (-jnp.arange(0, ROPE_DIM, 2, dtype=F32) / ROPE_DIM)
    ang = positions.astype(F32)[..., None] * inv_freq
    return jnp.cos(ang), jnp.sin(ang)


def apply_rope(t, cos, sin):
    t1, t2 = jnp.split(t.astype(F32), 2, axis=-1)
    return jnp.concatenate([t1 * cos - t2 * sin, t1 * sin + t2 * cos], axis=-1).astype(t.dtype)


def hgrn2_mixer(x, w_in, g_norm, w_o, lb):
    bsz, s_len, d = x.shape
    H, Dh, C = HG_HEADS, HG_HEAD_DIM, HG_CHUNK
    n_chunks = s_len // C
    q, f, i, g = jnp.split(x @ w_in, 4, axis=-1)
    q = jax.nn.silu(q.astype(F32))
    forget = lb + (1.0 - lb) * jax.nn.sigmoid(f.astype(F32))
    k = 1.0 - forget
    log_f = jnp.log(forget)

    def to_chunks(t):
        return t.astype(F32).reshape(bsz, n_chunks, C, H, Dh).transpose(1, 0, 3, 2, 4)

    causal = jnp.tril(jnp.ones((C, C), dtype=bool))

    def chunk_step(state, inp):
        qc, kc, ic, lc = inp
        b = jnp.cumsum(lc, axis=2)
        o_inter = jnp.einsum('bhtk,bhkv->bhtv', qc * jnp.exp(b), state)
        diff = b[:, :, :, None, :] - b[:, :, None, :, :]
        decay = jnp.exp(jnp.where(causal[:, :, None], diff, -jnp.inf))
        scores = jnp.einsum('bhtk,bhsk,bhtsk->bhts', qc, kc, decay)
        o_intra = jnp.einsum('bhts,bhsv->bhtv', scores, ic)
        b_last = b[:, :, -1:, :]
        state = jnp.exp(b_last[:, :, 0, :])[..., None] * state + jnp.einsum(
            'bhsk,bhsv->bhkv', kc * jnp.exp(b_last - b), ic)
        return state, o_inter + o_intra

    state0 = jnp.zeros((bsz, H, Dh, Dh), F32)
    _, o = lax.scan(chunk_step, state0, (to_chunks(q), to_chunks(k), to_chunks(i), to_chunks(log_f)))
    o = o.transpose(1, 0, 3, 2, 4).reshape(bsz, s_len, H, Dh)
    o = rms_norm(o, g_norm) * jax.nn.silu(g.astype(F32).reshape(bsz, s_len, H, Dh))
    return o.reshape(bsz, s_len, d).astype(x.dtype) @ w_o


def mla_shared_kv(h, kv_w_a, kv_norm, kv_w_b, cos, sin):
    bsz, s_len, _ = h.shape
    c_kv, k_r = jnp.split(h @ kv_w_a, [KV_RANK], axis=-1)
    c_kv = rms_norm(c_kv, kv_norm)
    kv = (c_kv @ kv_w_b).reshape(bsz, s_len, MLA_HEADS, NOPE_DIM + V_DIM)
    k_nope, v = jnp.split(kv, [NOPE_DIM], axis=-1)
    k_rope = apply_rope(k_r, cos, sin)
    return k_nope, k_rope, v


def mla_mixer(x, w_dq, q_norm, w_uq, w_o, k_nope, k_rope, v, cos, sin):
    bsz, s_len, _ = x.shape
    c_q = rms_norm(x @ w_dq, q_norm)
    q = (c_q @ w_uq).reshape(bsz, s_len, MLA_HEADS, NOPE_DIM + ROPE_DIM)
    q_nope, q_rope = jnp.split(q, [NOPE_DIM], axis=-1)
    q_rope = apply_rope(q_rope, cos[:, :, None, :], sin[:, :, None, :])
    scale = (NOPE_DIM + ROPE_DIM) ** -0.5
    outs = []
    for blk in range(s_len // Q_BLOCK):
        lo, hi = blk * Q_BLOCK, (blk + 1) * Q_BLOCK
        s = (jnp.einsum('bqhd,bkhd->bhqk', q_nope[:, lo:hi], k_nope[:, :hi])
             + jnp.einsum('bqhd,bkd->bhqk', q_rope[:, lo:hi], k_rope[:, :hi]))
        s = s.astype(F32) * scale
        mask = jnp.arange(hi)[None, :] <= jnp.arange(lo, hi)[:, None]
        p = jax.nn.softmax(jnp.where(mask, s, -jnp.inf), axis=-1).astype(v.dtype)
        outs.append(jnp.einsum('bhqk,bkhd->bqhd', p, v[:, :hi]))
    o = jnp.concatenate(outs, axis=1).reshape(bsz, s_len, MLA_HEADS * V_DIM)
    return o @ w_o


def moe_ffn(x, router_w, router_b, w1, b1, w2, b2):
    bsz, s_len, d = x.shape
    n_tok = bsz * s_len
    n_assign = n_tok * TOP_K
    x2 = x.reshape(n_tok, d)
    logits = (x2 @ router_w + router_b).astype(F32)
    top_v, top_e = lax.top_k(logits, TOP_K)
    gates = jax.nn.softmax(top_v, axis=-1)
    flat_e = top_e.reshape(n_assign)
    flat_tok = jnp.arange(n_assign, dtype=jnp.int32) // TOP_K
    flat_g = gates.reshape(n_assign)
    order = jnp.argsort(flat_e, stable=True)
    se, stok, sg = flat_e[order], flat_tok[order], flat_g[order]
    counts = jnp.bincount(flat_e, length=N_EXPERTS)
    starts = jnp.cumsum(counts) - counts
    padded = (counts + EXPERT_BLOCK - 1) // EXPERT_BLOCK * EXPERT_BLOCK
    pends = jnp.cumsum(padded)
    pstarts = pends - padded
    dest = pstarts[se] + jnp.arange(n_assign, dtype=jnp.int32) - starts[se]
    n_blocks = -(-n_assign // EXPERT_BLOCK) + N_EXPERTS
    n_rows = n_blocks * EXPERT_BLOCK
    row_tok = jnp.full((n_rows,), n_tok, jnp.int32).at[dest].set(stok)
    row_gate = jnp.zeros((n_rows,), F32).at[dest].set(sg)
    block_e = jnp.minimum(jnp.searchsorted(pends, jnp.arange(n_blocks, dtype=jnp.int32) * EXPERT_BLOCK,
                                           side='right'), N_EXPERTS - 1)

    def expert_block(args):
        tok, g, e = args
        xb = x2[jnp.minimum(tok, n_tok - 1)]
        h = xb @ w1[e] + b1[e]
        x_glu = jnp.minimum(h[:, ::2], SWIGLU_LIMIT)
        x_lin = jnp.clip(h[:, 1::2], -SWIGLU_LIMIT, SWIGLU_LIMIT)
        a = x_glu * jax.nn.sigmoid(SWIGLU_ALPHA * x_glu) * (x_lin + 1.0)
        y = a @ w2[e] + b2[e]
        return y * g[:, None].astype(y.dtype)

    y_rows = lax.map(expert_block, (row_tok.reshape(n_blocks, EXPERT_BLOCK),
                                    row_gate.reshape(n_blocks, EXPERT_BLOCK), block_e))
    out = jnp.zeros((n_tok, d), x.dtype).at[row_tok].add(
        y_rows.reshape(n_rows, d).astype(x.dtype), mode='drop')
    return out.reshape(bsz, s_len, d)


def setup_inputs(seed: int = 0) -> dict:
    key = jax.random.key(seed)
    ks = jax.random.split(key, 24)
    D, E, F = D_MODEL, N_EXPERTS, D_EXPERT
    nrm = lambda k, shape, scale: jax.random.normal(k, shape, F32) * scale
    return {
        'x': jax.random.normal(ks[0], (BATCH, SEQ, D), F32),
        'positions': jnp.broadcast_to(jnp.arange(SEQ, dtype=jnp.int32)[None, :], (BATCH, SEQ)),
        'ln_g': 1.0 + nrm(ks[1], (DEPTH, 2, D), 0.02),
        'ln_b': nrm(ks[2], (DEPTH, 2, D), 0.02),
        'hg_w_in': nrm(ks[3], (N_A, D, 4 * D), D ** -0.5),
        'hg_lb': nrm(ks[4], (N_A, D), 0.5),
        'hg_gnorm': 1.0 + nrm(ks[5], (N_A, HG_HEAD_DIM), 0.02),
        'hg_w_o': nrm(ks[6], (N_A, D, D), D ** -0.5 * DN_BETA),
        'mla_w_dq': nrm(ks[7], (N_B, D, Q_RANK), D ** -0.5),
        'mla_q_norm': 1.0 + nrm(ks[8], (N_B, Q_RANK), 0.02),
        'mla_w_uq': nrm(ks[9], (N_B, Q_RANK, MLA_HEADS * (NOPE_DIM + ROPE_DIM)), Q_RANK ** -0.5),
        'mla_w_o': nrm(ks[10], (N_B, MLA_HEADS * V_DIM, D), (MLA_HEADS * V_DIM) ** -0.5 * DN_BETA),
        'kv_w_a': nrm(ks[11], (D, KV_RANK + ROPE_DIM), D ** -0.5),
        'kv_norm': 1.0 + nrm(ks[12], (KV_RANK,), 0.02),
        'kv_w_b': nrm(ks[13], (KV_RANK, MLA_HEADS * (NOPE_DIM + V_DIM)), KV_RANK ** -0.5),
        'router_w': nrm(ks[14], (DEPTH, D, E), D ** -0.5),
        'router_b': nrm(ks[15], (DEPTH, E), 0.01),
        'moe_w1': nrm(ks[16], (DEPTH, E, D, 2 * F), D ** -0.5),
        'moe_b1': nrm(ks[17], (DEPTH, E, 2 * F), 0.01),
        'moe_w2': nrm(ks[18], (DEPTH, E, F, D), F ** -0.5 * DN_BETA),
        'moe_b2': nrm(ks[19], (DEPTH, E, D), 0.01),
    }


def reference(x, positions, ln_g, ln_b, hg_w_in, hg_lb, hg_gnorm, hg_w_o, mla_w_dq, mla_q_norm,
              mla_w_uq, mla_w_o, kv_w_a, kv_norm, kv_w_b, router_w, router_b, moe_w1, moe_b1,
              moe_w2, moe_b2):
    cos, sin = rope_tables(positions)
    lb_soft = jax.nn.softmax(hg_lb.astype(F32), axis=0)
    lower_bounds = jnp.cumsum(lb_soft, axis=0) - lb_soft[0]
    for layer in range(DEPTH):
        if layer < N_A:
            mix = hgrn2_mixer(x, hg_w_in[layer], hg_gnorm[layer], hg_w_o[layer], lower_bounds[layer])
        else:
            if layer == N_A:
                k_nope, k_rope, v = mla_shared_kv(x, kv_w_a, kv_norm, kv_w_b, cos, sin)
            j = layer - N_A
            mix = mla_mixer(x, mla_w_dq[j], mla_q_norm[j], mla_w_uq[j], mla_w_o[j],
                            k_nope, k_rope, v, cos, sin)
        x = layer_norm(DN_ALPHA * x + mix, ln_g[layer, 0], ln_b[layer, 0])
        ffn = moe_ffn(x, router_w[layer], router_b[layer], moe_w1[layer], moe_b1[layer],
                      moe_w2[layer], moe_b2[layer])
        x = layer_norm(DN_ALPHA * x + ffn, ln_g[layer, 1], ln_b[layer, 1])
    return x
```

```cpp
#include <hip/hip_runtime.h>
#include <cstdio>
#include <cstdint>
#ifndef MK_SINGLE
#define MK_SINGLE 0
#endif
namespace pg8 {

#define PG8_LAS __attribute__((address_space(3)))
typedef unsigned short bf16_t;
typedef short bf16x8 __attribute__((ext_vector_type(8)));
typedef float f32x4 __attribute__((ext_vector_type(4)));
typedef unsigned u32x4 __attribute__((ext_vector_type(4)));
constexpr int BM = 256, BK = 64, HALF = 128, HTB = HALF * BK * 2  , STAGE_BYTES = 8 * HTB, NXCD = 8, WGM = 8;

__host__ __device__ __forceinline__ int lds_byte(int r, int c) { const int st = (r >> 4) * 2 + (c >> 5), rr = r & 15, cc = c & 31, ob = rr * 64 + cc * 2; return st * 1024 + (ob ^ (((ob >> 9) & 1) << 5)); }
__host__ __device__ __forceinline__ void stage_rc(int b, int& R, int& C) { const int st = b / 1024, sb = b % 1024, swz = sb ^ (((sb >> 9) & 1) << 5); R = (st >> 1) * 16 + swz / 64; C = (st & 1) * 32 + (swz % 64) / 2; }
__host__ __device__ __forceinline__ int perm32(int rho) { const int n = rho >> 4, i = rho & 15; return 8 * (i >> 2) + 4 * n + (i & 3); }

struct Unit { int pm, pn, pb, e; };
struct Gemm { const bf16_t* A; const bf16_t* Bt; int M, N, K; };

struct StaticOrder {
    int nM, nN, nwg, G, c;
    __host__ __device__ void init(int M, int N, int G_, int c_) { nM = M / BM; nN = N / BM; nwg = nM * nN; G = G_; c = c_; }
    __host__ __device__ bool next(int i, Unit& u) const {
        const long L = (long)i * G + c; if (L >= nwg) return false;
        int wgid = (int)L; { const int q = nwg / NXCD, r = nwg % NXCD, xcd = wgid % NXCD, off = wgid / NXCD; wgid = (xcd < r ? xcd * (q + 1) : r * (q + 1) + (xcd - r) * q) + off; }
        const int nig = WGM * nN, gid = wgid / nig, fm = gid * WGM, gsz = (nM - fm) < WGM ? (nM - fm) : WGM;
        u.pm = fm + ((wgid % nig) % gsz); u.pn = (wgid % nig) / gsz; u.pb = u.pn; u.e = 0; return true;
    }
    __device__ __forceinline__ void a_ready(const Unit&) const {}
    __device__ __forceinline__ void done(const Unit&) const {}
};


__device__ __forceinline__ unsigned cvt_pk_bf16(float lo, float hi) { unsigned r; asm volatile("v_cvt_pk_bf16_f32 %0, %1, %2" : "=v"(r) : "v"(lo), "v"(hi)); return r; }
typedef unsigned u32x2 __attribute__((ext_vector_type(2)));
__device__ __forceinline__ float sigmoidf_(float v) { return __builtin_amdgcn_rcpf(1.0f + __expf(-v)); }
__device__ __forceinline__ float siluf_(float v) { return v * sigmoidf_(v); }
__device__ __forceinline__ u32x4 pack8(const f32x4 v0, const f32x4 v1) { u32x4 w; w.x = cvt_pk_bf16(v0[0], v0[1]); w.y = cvt_pk_bf16(v0[2], v0[3]); w.z = cvt_pk_bf16(v1[0], v1[1]); w.w = cvt_pk_bf16(v1[2], v1[3]); return w; }

struct EpiPlain {
    static constexpr bool PERM = true, AFTER_DRAIN = false;
    bf16_t* O; int ldc; float sc;
    __device__ __forceinline__ void operator()(const f32x4 (&acc)[2][2][4][2], const Unit& u, int wr, int wc, int fr, int fq) const {
        const int row0 = u.pm * BM + wr * 64 + fr, col0 = u.pn * BM + wc * 32 + 8 * fq;
#pragma unroll
        for (int ai = 0; ai < 2; ++ai)
#pragma unroll
            for (int m = 0; m < 4; ++m) { bf16_t* rowp = O + (size_t)(row0 + ai * HALF + m * 16) * ldc + col0;
#pragma unroll
                for (int bj = 0; bj < 2; ++bj) *(u32x4*)(rowp + bj * HALF) = pack8(acc[ai][bj][m][0] * sc, acc[ai][bj][m][1] * sc); }
    }
};
struct EpiHgIn {
    static constexpr bool PERM = true, AFTER_DRAIN = false;
    bf16_t* O; const float* lb;
    __device__ __forceinline__ void operator()(const f32x4 (&acc)[2][2][4][2], const Unit& u, int wr, int wc, int fr, int fq) const {
        const int row0 = u.pm * BM + wr * 64 + fr, col0 = u.pn * BM + wc * 32 + 8 * fq, kind = u.pn >> 2, ch0 = (u.pn & 3) * BM + wc * 32 + 8 * fq;
        f32x4 lbv[2][2];
#pragma unroll
        for (int bj = 0; bj < 2; ++bj)
#pragma unroll
            for (int n = 0; n < 2; ++n) lbv[bj][n] = (kind == 1) ? *(const f32x4*)(lb + ch0 + bj * HALF + 4 * n) : (f32x4){0.f, 0.f, 0.f, 0.f};
#pragma unroll
        for (int ai = 0; ai < 2; ++ai)
#pragma unroll
            for (int m = 0; m < 4; ++m) { bf16_t* rowp = O + (size_t)(row0 + ai * HALF + m * 16) * 4096 + col0;
#pragma unroll
                for (int bj = 0; bj < 2; ++bj) { f32x4 v[2] = {acc[ai][bj][m][0], acc[ai][bj][m][1]};
                    if (kind == 0 || kind == 3) {
#pragma unroll
                        for (int n = 0; n < 2; ++n)
#pragma unroll
                            for (int j = 0; j < 4; ++j) v[n][j] = siluf_(v[n][j]);
                    } else if (kind == 1) {
#pragma unroll
                        for (int n = 0; n < 2; ++n)
#pragma unroll
                            for (int j = 0; j < 4; ++j) { const float l = lbv[bj][n][j]; v[n][j] = __logf(l + (1.0f - l) * sigmoidf_(v[n][j])); }
                    }
                    *(u32x4*)(rowp + bj * HALF) = pack8(v[0], v[1]); } }
    }
};
struct EpiRes {
    static constexpr bool PERM = false, AFTER_DRAIN = false;
    const float* res; float* out; float alpha;
    __device__ __forceinline__ void operator()(const f32x4 (&acc)[2][2][4][2], const Unit& u, int wr, int wc, int fr, int fq) const {
        const int row0 = u.pm * BM + wr * 64 + fr, col0 = u.pn * BM + wc * 32 + 4 * fq;
#pragma unroll
        for (int ai = 0; ai < 2; ++ai)
#pragma unroll
            for (int m = 0; m < 4; ++m) { const size_t off = (size_t)(row0 + ai * HALF + m * 16) * 1024 + col0;
#pragma unroll
                for (int bj = 0; bj < 2; ++bj)
#pragma unroll
                    for (int n = 0; n < 2; ++n) { const f32x4 r = *(const f32x4*)(res + off + bj * HALF + n * 16); *(f32x4*)(out + off + bj * HALF + n * 16) = r * alpha + acc[ai][bj][m][n]; } }
    }
};
__device__ __forceinline__ void rope8(f32x4& v0, f32x4& v1, const float* cs) {
    const f32x4 c0 = *(const f32x4*)cs, c1 = *(const f32x4*)(cs + 4);
    const float a0 = v0[0], b0 = v0[1], a1 = v0[2], b1 = v0[3], a2 = v1[0], b2 = v1[1], a3 = v1[2], b3 = v1[3];
    v0[0] = a0 * c0[0] - b0 * c0[1]; v0[1] = a0 * c0[1] + b0 * c0[0]; v0[2] = a1 * c0[2] - b1 * c0[3]; v0[3] = a1 * c0[3] + b1 * c0[2];
    v1[0] = a2 * c1[0] - b2 * c1[1]; v1[1] = a2 * c1[1] + b2 * c1[0]; v1[2] = a3 * c1[2] - b3 * c1[3]; v1[3] = a3 * c1[3] + b3 * c1[2];
}
struct EpiKva {
    static constexpr bool PERM = true, AFTER_DRAIN = false;
    bf16_t* O; const float* rope;
    __device__ __forceinline__ void operator()(const f32x4 (&acc)[2][2][4][2], const Unit& u, int wr, int wc, int fr, int fq) const {
        const int row0 = u.pm * BM + wr * 64 + fr, col0 = wc * 32 + 8 * fq;
#pragma unroll
        for (int ai = 0; ai < 2; ++ai)
#pragma unroll
            for (int m = 0; m < 4; ++m) { const int row = row0 + ai * HALF + m * 16; bf16_t* rowp = O + (size_t)row * 256 + col0;
                *(u32x4*)(rowp) = pack8(acc[ai][0][m][0], acc[ai][0][m][1]);
                f32x4 v0 = acc[ai][1][m][0], v1 = acc[ai][1][m][1];
                if (wc < 2) rope8(v0, v1, rope + (size_t)row * 64 + (wc * 16 + 4 * fq) * 2);
                else { v0 = (f32x4){0.f, 0.f, 0.f, 0.f}; v1 = v0; }
                *(u32x4*)(rowp + HALF) = pack8(v0, v1); }
    }
};
struct EpiUq {
    static constexpr bool PERM = true, AFTER_DRAIN = false;
    bf16_t* O; const float* rope; float sc;
    __device__ __forceinline__ void operator()(const f32x4 (&acc)[2][2][4][2], const Unit& u, int wr, int wc, int fr, int fq) const {
        const int row0 = u.pm * BM + wr * 64 + fr, col0 = u.pn * BM + wc * 32 + 8 * fq;
#pragma unroll
        for (int ai = 0; ai < 2; ++ai)
#pragma unroll
            for (int m = 0; m < 4; ++m) { const int row = row0 + ai * HALF + m * 16; bf16_t* rowp = O + (size_t)row * 3072 + col0;
#pragma unroll
                for (int bj = 0; bj < 2; ++bj) { const int r = __builtin_amdgcn_readfirstlane((u.pn * BM + wc * 32 + bj * HALF) % 192) + 8 * fq; f32x4 v0 = acc[ai][bj][m][0] * sc, v1 = acc[ai][bj][m][1] * sc;
                    if (r >= 128) rope8(v0, v1, rope + (size_t)row * 64 + (r - 128));
                    *(u32x4*)(rowp + bj * HALF) = pack8(v0, v1); } }
    }
};
struct EpiMoe1 {
    static constexpr bool PERM = true, AFTER_DRAIN = false;
    bf16_t* O; const float* b1;
    __device__ __forceinline__ void operator()(const f32x4 (&acc)[2][2][4][2], const Unit& u, int wr, int wc, int fr, int fq) const {
        const int row0 = u.pm * BM + wr * 64 + fr, col0 = u.pn * BM + wc * 32 + 8 * fq;
        const float* bp = b1 + (size_t)u.e * 2048 + col0;
        f32x4 bv[2][2];
#pragma unroll
        for (int bj = 0; bj < 2; ++bj)
#pragma unroll
            for (int n = 0; n < 2; ++n) bv[bj][n] = *(const f32x4*)(bp + bj * HALF + 4 * n);
#pragma unroll
        for (int ai = 0; ai < 2; ++ai)
#pragma unroll
            for (int m = 0; m < 4; ++m) { bf16_t* rowp = O + (size_t)(row0 + ai * HALF + m * 16) * 1024 + (col0 >> 1);
#pragma unroll
                for (int bj = 0; bj < 2; ++bj) { const f32x4 v0 = acc[ai][bj][m][0] + bv[bj][0], v1 = acc[ai][bj][m][1] + bv[bj][1]; float o[4];
#pragma unroll
                    for (int p = 0; p < 4; ++p) { const float hg = (p < 2) ? v0[2 * p] : v1[2 * p - 4], hl = (p < 2) ? v0[2 * p + 1] : v1[2 * p - 3];
                        const float xg = fminf(hg, 7.0f), xl = fminf(fmaxf(hl, -7.0f), 7.0f); o[p] = xg * sigmoidf_(1.702f * xg) * (xl + 1.0f); }
                    u32x2 w; w.x = cvt_pk_bf16(o[0], o[1]); w.y = cvt_pk_bf16(o[2], o[3]); *(u32x2*)(rowp + bj * 64) = w; } }
    }
};
struct EpiMoe2 {
    static constexpr bool PERM = true, AFTER_DRAIN = false;
    bf16_t* O; const float* b2; const int* rslot; const float* rgate;
    __device__ __forceinline__ void operator()(const f32x4 (&acc)[2][2][4][2], const Unit& u, int wr, int wc, int fr, int fq) const {
        const int row0 = u.pm * BM + wr * 64 + fr, col0 = u.pn * BM + wc * 32 + 8 * fq;
        const float* bp = b2 + (size_t)u.e * 1024 + col0;
        f32x4 bv[2][2];
#pragma unroll
        for (int bj = 0; bj < 2; ++bj)
#pragma unroll
            for (int n = 0; n < 2; ++n) bv[bj][n] = *(const f32x4*)(bp + bj * HALF + 4 * n);
#pragma unroll
        for (int ai = 0; ai < 2; ++ai)
#pragma unroll
            for (int m = 0; m < 4; ++m) { const int row = row0 + ai * HALF + m * 16; const int slot = rslot[row]; const float g = rgate[row];
                if (slot >= 0) { bf16_t* rowp = O + (size_t)slot * 1024 + col0;
#pragma unroll
                    for (int bj = 0; bj < 2; ++bj) *(u32x4*)(rowp + bj * HALF) = pack8((acc[ai][bj][m][0] + bv[bj][0]) * g, (acc[ai][bj][m][1] + bv[bj][1]) * g); } }
    }
};
struct MoeOrder : StaticOrder {
    const PG8_LAS unsigned char* tile_e;
    __device__ __forceinline__ bool next(int i, Unit& u) const {
        if (!StaticOrder::next(i, u)) return false;
        u.e = __builtin_amdgcn_readfirstlane((int)tile_e[u.pm]); u.pb = u.e * nN + u.pn; return true;
    }
};

template <class Epi, class Sched, bool ALIGN_EPI = false, bool SP2 = false>
__device__ __forceinline__ void gemm_phase(PG8_LAS unsigned char* lds, const Gemm g, const Sched& S, const Epi& E) {
    int tid_ = threadIdx.x; asm volatile("" : "+v"(tid_));
    const int tid = tid_, wid = __builtin_amdgcn_readfirstlane(tid >> 6), lane = tid & 63, wr = wid >> 2, wc = wid & 3, fr = lane & 15, fq = lane >> 4;
    const int K = g.K, nt = K / BK;
    unsigned voffA[2], voffB[2];
#pragma unroll
    for (int i = 0; i < 2; ++i) { int R, C; stage_rc(tid * 16 + i * 8192, R, C); const int Rb = Epi::PERM ? ((R & ~31) + perm32(R & 31)) : R;
        voffA[i] = (unsigned)(R * K + C) * 2u; voffB[i] = (unsigned)(Rb * K + C) * 2u; }
    const size_t kstep = (size_t)(BK * 2);
    const size_t hstep = (size_t)HALF * K * 2;
    const size_t tstep = 2 * hstep;
    const unsigned ldsw = (unsigned)wid * 1024u;
    const int aoff = lds_byte(wr * 64 + fr, fq * 8), boff = lds_byte(wc * 32 + fr, fq * 8);
#define PG8_SA(b, h) (((b) * 2 + (h)) * HTB)
#define PG8_SB(b, h) ((4 + (b) * 2 + (h)) * HTB)
#define PG8_STAGE(bufoff, gbase, voff) do { _Pragma("unroll") for (int _i = 0; _i < 2; ++_i) \
        __builtin_amdgcn_global_load_lds((const unsigned*)((const char*)(gbase) + (voff)[_i]), (PG8_LAS unsigned*)(lds + (bufoff) + ldsw + _i * 8192), 16, 0, 0); } while (0)
#define PG8_LDA(dst, b, h) do { _Pragma("unroll") for (int m = 0; m < 4; ++m) _Pragma("unroll") for (int k = 0; k < 2; ++k) dst[m][k] = *(const PG8_LAS bf16x8*)(lds + PG8_SA(b, h) + aoff + m * 2048 + k * 1024); } while (0)
#define PG8_LDB(dst, b, h) do { _Pragma("unroll") for (int n = 0; n < 2; ++n) _Pragma("unroll") for (int k = 0; k < 2; ++k) dst[n][k] = *(const PG8_LAS bf16x8*)(lds + PG8_SB(b, h) + boff + n * 2048 + k * 1024); } while (0)
#define PG8_MMA(ai, bj, At, Bt) do { __builtin_amdgcn_s_setprio(1); _Pragma("unroll") for (int m = 0; m < 4; ++m) _Pragma("unroll") for (int n = 0; n < 2; ++n) _Pragma("unroll") for (int k = 0; k < 2; ++k) \
        acc[ai][bj][m][n] = __builtin_amdgcn_mfma_f32_16x16x32_bf16(Bt[n][k], At[m][k], acc[ai][bj][m][n], 0, 0, 0); __builtin_amdgcn_s_setprio(0); } while (0)
#define PG8_WAIT_V(n) asm volatile("s_waitcnt vmcnt(" #n ")" ::: "memory")
#define PG8_WAIT_L(n) asm volatile("s_waitcnt lgkmcnt(" #n ")" ::: "memory")
#define PG8_BAR __builtin_amdgcn_s_barrier()
#define PG8_SCHED __builtin_amdgcn_sched_barrier(0)
    Unit cur, nxt; int ui = 0;
    if (!S.next(0, cur)) return;
    f32x4 acc[2][2][4][2];
#pragma unroll
    for (int a = 0; a < 2; ++a)
#pragma unroll
        for (int b = 0; b < 2; ++b)
#pragma unroll
            for (int m = 0; m < 4; ++m)
#pragma unroll
                for (int n = 0; n < 2; ++n) acc[a][b][m][n] = (f32x4){0.f, 0.f, 0.f, 0.f};
    bf16x8 At[4][2], B0[2][2], B1[2][2];
    const char* cA = (const char*)g.A + (size_t)cur.pm * tstep; const char* cB = (const char*)g.Bt + (size_t)cur.pb * tstep;
    S.a_ready(cur);
    if constexpr (SP2) {
        PG8_STAGE(PG8_SB(0, 0), cB, voffB); PG8_STAGE(PG8_SB(0, 1), cB + hstep, voffB); PG8_STAGE(PG8_SA(0, 0), cA, voffA); PG8_STAGE(PG8_SA(0, 1), cA + hstep, voffA);
        if (wr == 1) PG8_BAR;
        PG8_WAIT_V(2); PG8_BAR;
        PG8_STAGE(PG8_SB(1, 0), cB + kstep, voffB); PG8_STAGE(PG8_SA(1, 0), cA + kstep, voffA); PG8_STAGE(PG8_SB(1, 1), cB + hstep + kstep, voffB);
        PG8_WAIT_V(6); PG8_BAR;
    } else {
        PG8_STAGE(PG8_SB(0, 0), cB, voffB); PG8_STAGE(PG8_SA(0, 0), cA, voffA); PG8_STAGE(PG8_SB(0, 1), cB + hstep, voffB); PG8_STAGE(PG8_SA(0, 1), cA + hstep, voffA);
        if (wr == 1) PG8_BAR;
        PG8_WAIT_V(4); PG8_BAR;
        PG8_STAGE(PG8_SB(1, 0), cB + kstep, voffB); PG8_STAGE(PG8_SA(1, 0), cA + kstep, voffA); PG8_STAGE(PG8_SB(1, 1), cB + hstep + kstep, voffB);
        PG8_WAIT_V(6); PG8_BAR;
    }
    for (;;) {
        const bool has_next = S.next(ui + 1, nxt);
        const char* nA = has_next ? (const char*)g.A + (size_t)nxt.pm * tstep : cA; const char* nB = has_next ? (const char*)g.Bt + (size_t)nxt.pb * tstep : cB;
        for (int t = 0; t < nt; t += 2) {
            const bool last = (t == nt - 2);
            const char* a1 = cA + (size_t)(t + 1) * kstep;
            const char* a2 = last ? nA : cA + (size_t)(t + 2) * kstep; const char* b2 = last ? nB : cB + (size_t)(t + 2) * kstep;
            const char* a3 = a2 + kstep; const char* b3 = b2 + kstep;
            if (last && has_next) S.a_ready(nxt);
            if constexpr (SP2) {
            PG8_LDB(B0, 0, 0); PG8_LDB(B1, 0, 1); PG8_SCHED; PG8_LDA(At, 0, 0); PG8_STAGE(PG8_SA(1, 1), a1 + hstep, voffA);
            PG8_WAIT_V(8); PG8_WAIT_L(0); PG8_BAR; PG8_MMA(0, 0, At, B0); PG8_MMA(0, 1, At, B1); PG8_BAR; PG8_SCHED;
            PG8_LDA(At, 0, 1); PG8_STAGE(PG8_SB(0, 0), b2, voffB); PG8_STAGE(PG8_SB(0, 1), b2 + hstep, voffB); PG8_STAGE(PG8_SA(0, 0), a2, voffA);
            PG8_WAIT_V(8); PG8_WAIT_L(0); PG8_BAR; PG8_MMA(1, 0, At, B0); PG8_MMA(1, 1, At, B1); PG8_BAR; PG8_SCHED;
            PG8_LDB(B0, 1, 0); PG8_LDB(B1, 1, 1); PG8_SCHED; PG8_LDA(At, 1, 0); PG8_STAGE(PG8_SA(0, 1), a2 + hstep, voffA);
            PG8_WAIT_V(8); PG8_WAIT_L(0); PG8_BAR; PG8_MMA(0, 0, At, B0); PG8_MMA(0, 1, At, B1); PG8_BAR; PG8_SCHED;
            PG8_LDA(At, 1, 1); PG8_STAGE(PG8_SB(1, 0), b3, voffB); PG8_STAGE(PG8_SB(1, 1), b3 + hstep, voffB); PG8_STAGE(PG8_SA(1, 0), a3, voffA);
            PG8_WAIT_V(8); PG8_WAIT_L(0); PG8_BAR; PG8_MMA(1, 0, At, B0); PG8_MMA(1, 1, At, B1); PG8_BAR; PG8_SCHED;
            } else {
            PG8_LDB(B0, 0, 0); PG8_SCHED; PG8_LDA(At, 0, 0); PG8_STAGE(PG8_SA(1, 1), a1 + hstep, voffA);
            PG8_WAIT_L(8); PG8_BAR; PG8_WAIT_L(0); PG8_MMA(0, 0, At, B0); PG8_BAR; PG8_SCHED;
            PG8_LDB(B1, 0, 1); PG8_STAGE(PG8_SB(0, 0), b2, voffB);
            PG8_BAR; PG8_WAIT_L(0); PG8_MMA(0, 1, At, B1); PG8_BAR;
            PG8_LDA(At, 0, 1); PG8_STAGE(PG8_SA(0, 0), a2, voffA);
            PG8_BAR; PG8_WAIT_L(0); PG8_MMA(1, 0, At, B0); PG8_BAR; PG8_SCHED;
            PG8_STAGE(PG8_SB(0, 1), b2 + hstep, voffB);
            PG8_WAIT_V(6); PG8_BAR; PG8_MMA(1, 1, At, B1); PG8_BAR;
            PG8_LDB(B0, 1, 0); PG8_SCHED; PG8_LDA(At, 1, 0); PG8_STAGE(PG8_SA(0, 1), a2 + hstep, voffA);
            PG8_WAIT_L(8); PG8_BAR; PG8_WAIT_L(0); PG8_MMA(0, 0, At, B0); PG8_BAR; PG8_SCHED;
            PG8_LDB(B1, 1, 1); PG8_STAGE(PG8_SB(1, 0), b3, voffB);
            PG8_BAR; PG8_WAIT_L(0); PG8_MMA(0, 1, At, B1); PG8_BAR;
            PG8_LDA(At, 1, 1); PG8_STAGE(PG8_SA(1, 0), a3, voffA);
            PG8_BAR; PG8_WAIT_L(0); PG8_MMA(1, 0, At, B0); PG8_BAR; PG8_SCHED;
            PG8_STAGE(PG8_SB(1, 1), b3 + hstep, voffB);
            PG8_WAIT_V(6); PG8_BAR; PG8_MMA(1, 1, At, B1); PG8_BAR;
            }
        }
        if constexpr (ALIGN_EPI) { if (wr == 0) PG8_BAR; }
        if constexpr (!Epi::AFTER_DRAIN) { int fr2 = fr, fq2 = fq; asm volatile("" : "+v"(fr2), "+v"(fq2));
            E(acc, cur, wr, wc, fr2, fq2); S.done(cur); }
        if (!has_next) break;
#pragma unroll
        for (int a = 0; a < 2; ++a)
#pragma unroll
            for (int b = 0; b < 2; ++b)
#pragma unroll
                for (int m = 0; m < 4; ++m)
#pragma unroll
                    for (int n = 0; n < 2; ++n) acc[a][b][m][n] = (f32x4){0.f, 0.f, 0.f, 0.f};
        cur = nxt; cA = nA; cB = nB; ++ui;
        if constexpr (ALIGN_EPI) { if (wr == 1) PG8_BAR; }
    }
    PG8_WAIT_V(0);
    if constexpr (!ALIGN_EPI) { if (wr == 0) PG8_BAR; }
    PG8_BAR;
    if constexpr (Epi::AFTER_DRAIN) { E.fused(acc, cur, wr, wc, fr, fq, lds, wid, lane); S.done(cur); }
#undef PG8_SA
#undef PG8_SB
#undef PG8_STAGE
#undef PG8_LDA
#undef PG8_LDB
#undef PG8_MMA
#undef PG8_WAIT_V
#undef PG8_WAIT_L
#undef PG8_BAR
#undef PG8_SCHED
}
}

#define GAS __attribute__((address_space(1)))
#define LAS __attribute__((address_space(3)))
typedef unsigned short bf16;
typedef unsigned v4u __attribute__((ext_vector_type(4)));
typedef float f32x4 __attribute__((ext_vector_type(4)));
typedef short bf16x8 __attribute__((ext_vector_type(8)));
typedef GAS unsigned gu32;
typedef GAS unsigned long long gu64;
#define RLX_AGENT __ATOMIC_RELAXED, __HIP_MEMORY_SCOPE_AGENT
#define LDS_WAIT() asm volatile("s_waitcnt lgkmcnt(0)" ::: "memory")
#define VM_WAIT() asm volatile("s_waitcnt vmcnt(0)" ::: "memory")
__device__ __forceinline__ unsigned long long rt() { return __builtin_amdgcn_s_memrealtime(); }
__device__ __forceinline__ unsigned f2bf(float f) { unsigned u = __builtin_bit_cast(unsigned, f); return (u + 0x7fffu + ((u >> 16) & 1u)) >> 16; }
__device__ __forceinline__ unsigned pk2(float lo, float hi) { return f2bf(lo) | (f2bf(hi) << 16); }

#define XB_TMO      128
#define XB_XCNT(j)  (256  + 64 * (j))
#define XB_XSUB(j)  (1280 + 64 * (j))
#define XB_XGEN(j)  (2304 + 64 * (j))
#define XB_TOP      3328
#define XB_TOPGEN   3392
#define XCD_BAR_WORDS 3456
#define XB_SPIN_CAP (1u << 20)

__device__ __forceinline__ unsigned xb_ld(unsigned* p)              { return __hip_atomic_load(p, __ATOMIC_RELAXED, __HIP_MEMORY_SCOPE_AGENT); }
__device__ __forceinline__ unsigned xb_add(unsigned* p, unsigned v) { return __hip_atomic_fetch_add(p, v, __ATOMIC_RELAXED, __HIP_MEMORY_SCOPE_AGENT); }
__device__ __forceinline__ unsigned xb_xcc_id() { return (unsigned)__builtin_amdgcn_s_getreg((3 << 11) | 20) & 0xFu; }
#define XB_SPIN(cond, bar) do { unsigned _sp = 0; while (cond) { __builtin_amdgcn_s_sleep(1); \
    if ((++_sp & 255u) == 0u) { if (xb_ld(&(bar)[XB_TMO])) break; if (_sp > XB_SPIN_CAP) { atomicAdd(&(bar)[XB_TMO], 1u); break; } } } } while (0)

struct XcdBarrier {
    unsigned* bar; unsigned x;
    volatile LAS unsigned* st;
};

__device__ __forceinline__ XcdBarrier xcd_barrier_post(unsigned* bar, volatile LAS unsigned* st) {
    XcdBarrier b; b.bar = bar; b.x = xb_xcc_id(); b.st = st;
    if (threadIdx.x == 0) (void)xb_add(&bar[XB_XCNT(b.x)], 1u);
    return b;
}
__device__ __forceinline__ void xcd_barrier_complete(unsigned* bar, unsigned x, unsigned& nloc, unsigned& nx) {
    const unsigned G = gridDim.x * gridDim.y * gridDim.z;
    unsigned sum, cnt, mine, sp = 0u;
    for (;;) {
        sum = 0u; cnt = 0u; mine = 0u;
#pragma unroll
        for (unsigned j = 0; j < 16; ++j) { const unsigned c = xb_ld(&bar[XB_XCNT(j)]); sum += c; cnt += (c > 0u) ? 1u : 0u; mine = (j == x) ? c : mine; }
        if (sum == G) break;
        __builtin_amdgcn_s_sleep(1);
        if ((++sp & 255u) == 0u) { if (xb_ld(&bar[XB_TMO])) break; if (sp > XB_SPIN_CAP) { atomicAdd(&bar[XB_TMO], 1u); break; } }
    }
    nloc = mine > 0u ? mine : 1u; nx = cnt > 0u ? cnt : 1u;
}

__device__ __forceinline__ void xcd_barrier(const XcdBarrier& b) {
    asm volatile("s_waitcnt vmcnt(0)" ::: "memory");
    __syncthreads();
    if (threadIdx.x == 0) {
        unsigned* bar = b.bar; asm volatile("" : "+s"(bar));
        __builtin_amdgcn_s_waitcnt(0);
        unsigned nloc = b.st[0], nx = b.st[1];
        if (nloc == 0u) { xcd_barrier_complete(bar, b.x, nloc, nx); b.st[0] = nloc; b.st[1] = nx; }
        const unsigned old = xb_add(&bar[XB_XSUB(b.x)], 1u);
        const unsigned gen = old / nloc;
        if (old + 1u == (gen + 1u) * nloc) {
            __builtin_amdgcn_fence(__ATOMIC_RELEASE, "agent");
            asm volatile("s_waitcnt vmcnt(0)" ::: "memory");
            const unsigned og = xb_add(&bar[XB_TOP], 1u);
            const unsigned tg = og / nx;
            if (og + 1u == (tg + 1u) * nx) xb_add(&bar[XB_TOPGEN], 1u);
            else XB_SPIN(xb_ld(&bar[XB_TOPGEN]) == tg, bar);
            __builtin_amdgcn_fence(__ATOMIC_ACQUIRE, "agent");
            xb_add(&bar[XB_XGEN(b.x)], 1u);
            asm volatile("s_waitcnt vmcnt(0)" ::: "memory");
        } else {
            XB_SPIN(xb_ld(&bar[XB_XGEN(b.x)]) == gen, bar);
            __builtin_amdgcn_fence(__ATOMIC_ACQUIRE, "agent");
            asm volatile("s_waitcnt vmcnt(0)" ::: "memory");
        }
    }
    __syncthreads();
}


constexpr int NWAVES = 8, NTHR = 512;
constexpr int BATCH = 32, SEQ = 2048, T = BATCH * SEQ, D = 1024, DEPTH = 4, N_A = 2;
constexpr int HGH = 8, HGD = 128;
constexpr int MH = 16, QR = 256, KVR = 128, QKD = 192, VD = 128;
constexpr int NE = 32, TOPK = 4, FF = 1024;
constexpr int NASSIGN = T * TOPK, MAXTILES = NASSIGN / 256 + NE, MAXROWS = MAXTILES * 256;
constexpr float DN_ALPHA = 1.6817928305074290f;
constexpr float LN_EPS = 1e-5f, RMS_EPS = 1e-6f;
constexpr float QSCALE = 0.07216878364870322f * 1.4426950408889634f;

constexpr size_t MiB = 1u << 20;
constexpr size_t WS_CTL = 0, CTL_ZERO_BYTES = 1 * MiB;
constexpr size_t WS_LBTAB = 1 * MiB;
constexpr size_t WS_ROPE = 2 * MiB;
constexpr size_t WS_HGWIN = 18 * MiB;
constexpr size_t WS_HGWO = 34 * MiB;
constexpr size_t WS_DQ = 38 * MiB;
constexpr size_t WS_UQ = 39 * MiB;
constexpr size_t WS_MWO = 42 * MiB;
constexpr size_t WS_KVA = 50 * MiB;
constexpr size_t WS_KVB = 51 * MiB;
constexpr size_t WS_W1 = 64 * MiB;
constexpr size_t WS_W2 = 576 * MiB;
constexpr size_t WS_XB = 832 * MiB;
constexpr size_t WS_TBUF = 960 * MiB;
constexpr size_t WS_BIG = 1216 * MiB;
constexpr size_t WS_ABUF = 1744 * MiB;
constexpr size_t WS_KN = 2272 * MiB;
constexpr size_t WS_VT = 2528 * MiB;
constexpr size_t WS_CKV = 2784 * MiB;
constexpr size_t WS_CQ = 2816 * MiB;
constexpr size_t WS_SELE = 2848 * MiB;
constexpr size_t WS_SELG = 2849 * MiB;
constexpr size_t WS_APOS = 2850 * MiB;
constexpr size_t WS_RSLOT = 2851 * MiB;
constexpr size_t WS_RGATE = 2853 * MiB;
constexpr size_t WS_END = 2856 * MiB;
static_assert((size_t)MAXROWS * 1024 * 2 <= 528 * MiB && (size_t)MAXROWS * 4 <= 2 * MiB, "ws map");
constexpr int CW_TMO = 0, CW_CODE = 1, CW_BAR = 4096, CW_CNT = 8192;
static_assert((CW_CNT + DEPTH * NE * 16) * 4 <= (int)CTL_ZERO_BYTES, "ctl");

constexpr int RING_OFF = 0, RING_BYTES = 131072;
constexpr int LDSCTL_OFF = RING_BYTES, MISC_OFF = LDSCTL_OFF + 320;
constexpr int TAB_OFF = RING_BYTES + 512;
constexpr int TAB_TSTART = TAB_OFF, TAB_TILEE = TAB_OFF + 256, TAB_LCNT = TAB_TILEE + 1280, TAB_LBASE = TAB_LCNT + 128, TAB_AE = TAB_LBASE + 128, TAB_ARANK = TAB_AE + 4096, TAB_END = TAB_ARANK + 4096;
constexpr int LDS_BYTES = 147456;
static_assert(TAB_END <= LDS_BYTES && MAXTILES <= 1280, "LDS map");

struct Args {
    const float* x; const int* pos; const float* ln_g; const float* ln_b; const float* hg_w_in; const float* hg_lb; const float* hg_gnorm; const float* hg_w_o;
    const float* mla_w_dq; const float* mla_q_norm; const float* mla_w_uq; const float* mla_w_o; const float* kv_w_a; const float* kv_norm; const float* kv_w_b;
    const float* router_w; const float* router_b; const float* moe_w1; const float* moe_b1; const float* moe_w2; const float* moe_b2;
    float* out; unsigned char* ws; int st_lo, st_hi, single, pad;
};

__device__ __forceinline__ float wave_sum(float v) {
#pragma unroll
    for (int o = 1; o < 64; o <<= 1) v += __shfl_xor(v, o);
    return v;
}
__device__ __forceinline__ float bf2f(unsigned short b) { return __builtin_bit_cast(float, (unsigned)b << 16); }
__device__ __forceinline__ float bflo(unsigned w) { return __builtin_bit_cast(float, w << 16); }
__device__ __forceinline__ float bfhi(unsigned w) { return __builtin_bit_cast(float, w & 0xffff0000u); }
__device__ __forceinline__ unsigned cvtpk(float lo, float hi) { return pg8::cvt_pk_bf16(lo, hi); }

__device__ __forceinline__ int map_row(int mode, int n) {
    if (mode == 1) { const int h = n / 192, r = n - h * 192; if (r < 128) return n; const int j = r - 128; return h * 192 + 128 + 2 * (j & 31) + (j >> 5); }
    if (mode == 2) { if (n < 128) return n; const int j = n - 128; return 128 + 2 * (j & 31) + (j >> 5); }
    if (mode == 3) { const int h = n >> 8, r = n & 255; return (r < 128 ? 0 : 2048) + h * 128 + (r & 127); }
    return n;
}
__device__ __forceinline__ void transpose_item(const float* W, int K, int N, bf16* WT, int ldk, int mode, LAS float* scr, int item, int lane) {
    const int nblk = N / 32, kb = item / nblk, nb = item % nblk, k0 = 64 * kb, n0 = 32 * nb;
#pragma unroll 8
    for (int i = 0; i < 32; ++i) { const int kk = 2 * i + (lane >> 5); scr[kk * 33 + (lane & 31)] = W[(size_t)(k0 + kk) * N + n0 + (lane & 31)]; }
    LDS_WAIT(); asm volatile("" ::: "memory");
    const int c = lane & 7;
#pragma unroll
    for (int j = 0; j < 4; ++j) { const int n = (lane >> 3) + 8 * j; const LAS float* s = scr + (8 * c) * 33 + n;
        v4u o; o.x = cvtpk(s[0 * 33], s[1 * 33]); o.y = cvtpk(s[2 * 33], s[3 * 33]); o.z = cvtpk(s[4 * 33], s[5 * 33]); o.w = cvtpk(s[6 * 33], s[7 * 33]);
        *(GAS v4u*)(WT + (size_t)map_row(mode, n0 + n) * ldk + k0 + 8 * c) = o; }
    LDS_WAIT(); asm volatile("" ::: "memory");
}
__device__ __forceinline__ void p0_prologue(const Args& A, LAS unsigned char* lds, int vcu, int G, int wave, int lane, int tid) {
    unsigned char* ws = A.ws;
    LAS float* scr = (LAS float*)(lds + RING_OFF + wave * 16384);
    const int gw = vcu * NWAVES + wave, NGW = G * NWAVES;
    constexpr int I_W1 = 128 * 16 * 64, I_W2 = 128 * 16 * 32, I_HIN = 2 * 16 * 128, I_HWO = 2 * 16 * 32, I_DQ = 2 * 16 * 8, I_UQ = 2 * 4 * 96, I_MWO = 2 * 32 * 32, I_KVA = 16 * 6, I_KVB = 2 * 128;
    constexpr int NITEMS = I_W1 + I_W2 + I_HIN + I_HWO + I_DQ + I_UQ + I_MWO + I_KVA + I_KVB;
    for (int it = gw; it < NITEMS; it += NGW) {
        int r = it;
        if (r < I_W1) { const int mat = r >> 10; transpose_item(A.moe_w1 + (size_t)mat * 1024 * 2048, 1024, 2048, (bf16*)(ws + WS_W1) + (size_t)mat * 2048 * 1024, 1024, 0, scr, r & 1023, lane); continue; } r -= I_W1;
        if (r < I_W2) { const int mat = r >> 9; transpose_item(A.moe_w2 + (size_t)mat * 1024 * 1024, 1024, 1024, (bf16*)(ws + WS_W2) + (size_t)mat * 1024 * 1024, 1024, 0, scr, r & 511, lane); continue; } r -= I_W2;
        if (r < I_HIN) { const int mat = r / 2048; transpose_item(A.hg_w_in + (size_t)mat * 1024 * 4096, 1024, 4096, (bf16*)(ws + WS_HGWIN) + (size_t)mat * 4096 * 1024, 1024, 0, scr, r % 2048, lane); continue; } r -= I_HIN;
        if (r < I_HWO) { const int mat = r / 512; transpose_item(A.hg_w_o + (size_t)mat * 1024 * 1024, 1024, 1024, (bf16*)(ws + WS_HGWO) + (size_t)mat * 1024 * 1024, 1024, 0, scr, r % 512, lane); continue; } r -= I_HWO;
        if (r < I_DQ) { const int mat = r / 128; transpose_item(A.mla_w_dq + (size_t)mat * 1024 * 256, 1024, 256, (bf16*)(ws + WS_DQ) + (size_t)mat * 256 * 1024, 1024, 0, scr, r % 128, lane); continue; } r -= I_DQ;
        if (r < I_UQ) { const int mat = r / 384; transpose_item(A.mla_w_uq + (size_t)mat * 256 * 3072, 256, 3072, (bf16*)(ws + WS_UQ) + (size_t)mat * 3072 * 256, 256, 1, scr, r % 384, lane); continue; } r -= I_UQ;
        if (r < I_MWO) { const int mat = r / 1024; transpose_item(A.mla_w_o + (size_t)mat * 2048 * 1024, 2048, 1024, (bf16*)(ws + WS_MWO) + (size_t)mat * 1024 * 2048, 2048, 0, scr, r % 1024, lane); continue; } r -= I_MWO;
        if (r < I_KVA) { transpose_item(A.kv_w_a, 1024, 192, (bf16*)(ws + WS_KVA), 1024, 2, scr, r, lane); continue; } r -= I_KVA;
        transpose_item(A.kv_w_b, 128, 4096, (bf16*)(ws + WS_KVB), 256, 3, scr, r, lane);
    }
    const int gt = vcu * NTHR + tid, NGT = G * NTHR;
    for (int i = gt; i < 8192; i += NGT) *(GAS v4u*)(ws + WS_KVA + (size_t)192 * 2048 + (size_t)i * 16) = (v4u){0u, 0u, 0u, 0u};
    for (int i = gt; i < 4096 * 16; i += NGT) *(GAS v4u*)(ws + WS_KVB + (size_t)(i >> 4) * 512 + 256 + (size_t)(i & 15) * 16) = (v4u){0u, 0u, 0u, 0u};
    for (int i = gt; i < 2048; i += NGT) { float v = 0.f; if (i >= 1024) { const float a = A.hg_lb[i - 1024], b = A.hg_lb[i]; v = 1.0f / (1.0f + expf(a - b)); } ((float*)(ws + WS_LBTAB))[i] = v; }
    for (int i = gt; i < T * 32; i += NGT) { const int tok = i >> 5, j = i & 31; const float inv = exp2f(-(float)j * (13.287712379549449f / 32.0f)); const float ang = (float)A.pos[tok] * inv; const double rev = (double)ang * 0.15915494309189535; const float fr = (float)(rev - rint(rev)); const float s = __builtin_amdgcn_sinf(fr), c = __builtin_amdgcn_cosf(fr);
        ((float2*)(ws + WS_ROPE))[i] = make_float2(c, s); }
    for (int m = gw; m < T; m += NGW) { const GAS f32x4* xr = (const GAS f32x4*)(A.x + (size_t)m * D) + lane; GAS unsigned long long* o8 = (GAS unsigned long long*)((bf16*)(ws + WS_XB) + (size_t)m * D) + lane;
#pragma unroll
        for (int j = 0; j < 4; ++j) { const f32x4 v = xr[64 * j]; o8[64 * j] = (unsigned long long)cvtpk(v.x, v.y) | ((unsigned long long)cvtpk(v.z, v.w) << 32); } }
}

__device__ __forceinline__ void hg_scan_unit(const Args& A, int layer, int bh, LAS unsigned char* lds, int tid) {
    const int b = bh >> 3, h = bh & 7, v = tid & 127, kq = tid >> 7;
    const bf16* qfig = (const bf16*)(A.ws + WS_BIG); bf16* og = (bf16*)(A.ws + WS_ABUF);
    LAS float* Lq = (LAS float*)lds; LAS float* Lf = Lq + 4096; LAS float* Lk = Lf + 4096; LAS float* Li = Lk + 4096; LAS float* Po = Li + 4096;
    float S[32];
#pragma unroll
    for (int i = 0; i < 32; ++i) S[i] = 0.f;
    const int lt = tid >> 4, v0 = (tid & 15) * 8;
    f32x4 gn0 = *(const f32x4*)(A.hg_gnorm + layer * 128 + v0), gn1 = *(const f32x4*)(A.hg_gnorm + layer * 128 + v0 + 4);
    for (int t0 = 0; t0 < SEQ; t0 += 32) {
        const size_t rowoff = ((size_t)b * SEQ + t0 + lt) * 4096 + h * 128 + v0;
        const v4u wq = *(const GAS v4u*)(qfig + rowoff), wf = *(const GAS v4u*)(qfig + rowoff + 1024), wi = *(const GAS v4u*)(qfig + rowoff + 2048);
        const unsigned aq[4] = {wq.x, wq.y, wq.z, wq.w}, af[4] = {wf.x, wf.y, wf.z, wf.w}, ai[4] = {wi.x, wi.y, wi.z, wi.w};
#pragma unroll
        for (int j = 0; j < 4; ++j) { const int o = lt * 128 + v0 + 2 * j;
            Lq[o] = bflo(aq[j]); Lq[o + 1] = bfhi(aq[j]); Li[o] = bflo(ai[j]); Li[o + 1] = bfhi(ai[j]);
            const float f0 = __expf(bflo(af[j])), f1 = __expf(bfhi(af[j])); Lf[o] = f0; Lf[o + 1] = f1; Lk[o] = 1.0f - f0; Lk[o + 1] = 1.0f - f1; }
        __syncthreads();
        for (int t = 0; t < 32; ++t) {
            const float iv = Li[t * 128 + v]; float o = 0.f;
            const LAS f32x4* pf = (const LAS f32x4*)(Lf + t * 128 + kq * 32); const LAS f32x4* pk = (const LAS f32x4*)(Lk + t * 128 + kq * 32); const LAS f32x4* pq = (const LAS f32x4*)(Lq + t * 128 + kq * 32);
#pragma unroll
            for (int k4 = 0; k4 < 8; ++k4) { const f32x4 f4 = pf[k4], kk4 = pk[k4], q4 = pq[k4];
#pragma unroll
                for (int j = 0; j < 4; ++j) { S[4 * k4 + j] = f4[j] * S[4 * k4 + j] + kk4[j] * iv; o += S[4 * k4 + j] * q4[j]; } }
            Po[(kq * 32 + t) * 128 + v] = o;
        }
        __syncthreads();
        {
            float o8[8]; float ss = 0.f;
#pragma unroll
            for (int j = 0; j < 8; ++j) { o8[j] = (Po[(0 * 32 + lt) * 128 + v0 + j] + Po[(1 * 32 + lt) * 128 + v0 + j]) + (Po[(2 * 32 + lt) * 128 + v0 + j] + Po[(3 * 32 + lt) * 128 + v0 + j]); ss += o8[j] * o8[j]; }
            ss += __shfl_xor(ss, 1); ss += __shfl_xor(ss, 2); ss += __shfl_xor(ss, 4); ss += __shfl_xor(ss, 8);
            const float rstd = 1.0f / sqrtf(ss * (1.0f / 128.0f) + RMS_EPS);
            const v4u wg = *(const GAS v4u*)(qfig + rowoff + 3072); const unsigned ag[4] = {wg.x, wg.y, wg.z, wg.w};
            const float gn[8] = {gn0[0], gn0[1], gn0[2], gn0[3], gn1[0], gn1[1], gn1[2], gn1[3]};
            unsigned w[4];
#pragma unroll
            for (int j = 0; j < 4; ++j) w[j] = cvtpk(o8[2 * j] * rstd * gn[2 * j] * bflo(ag[j]), o8[2 * j + 1] * rstd * gn[2 * j + 1] * bfhi(ag[j]));
            *(GAS v4u*)(og + ((size_t)b * SEQ + t0 + lt) * 1024 + h * 128 + v0) = (v4u){w[0], w[1], w[2], w[3]};
        }
    }
    __syncthreads();
}

typedef float f32x16 __attribute__((ext_vector_type(16)));
typedef short s16x4 __attribute__((ext_vector_type(4)));
constexpr int AT_KROW = 400, AT_VROW = 144, AT_KB = 64 * AT_KROW, AT_VB = 128 * AT_VROW;
static_assert(2 * (AT_KB + AT_VB) <= RING_BYTES, "attention LDS");
__device__ __forceinline__ int crow(int r, int hi) { return (r & 3) + 8 * (r >> 2) + 4 * hi; }
__device__ __forceinline__ void attn_unit(const Args& A, int b, int h, int qb, LAS unsigned char* lds, int tid) {
    const int lane = tid & 63, wid = __builtin_amdgcn_readfirstlane(tid >> 6), r32 = lane & 31, hi = lane >> 5;
    const bf16* qbuf = (const bf16*)(A.ws + WS_BIG); const bf16* kn = (const bf16*)(A.ws + WS_KN); const bf16* vt = (const bf16*)(A.ws + WS_VT); const bf16* ckv = (const bf16*)(A.ws + WS_CKV);
    bf16* obuf = (bf16*)(A.ws + WS_ABUF);
    const int q0 = qb * 256, qrow = q0 + wid * 32 + r32; const size_t tokq = (size_t)b * SEQ + qrow;
    bf16x8 qf[12];
    { const bf16* Qp = qbuf + tokq * 3072 + h * 192 + hi * 8;
#pragma unroll
      for (int s = 0; s < 12; ++s) qf[s] = *(const GAS bf16x8*)(Qp + s * 16); }
    f32x16 o[4];
#pragma unroll
    for (int d = 0; d < 4; ++d)
#pragma unroll
        for (int i = 0; i < 16; ++i) o[d][i] = 0.f;
    float m_run = -1e30f, l_run = 0.f;
    const int NT = 4 * qb + 4;
    v4u st[5];
    const size_t tok0 = (size_t)b * SEQ;
    const bf16* kp = kn + (tok0 + (tid >> 3)) * 2048 + h * 128 + (tid & 7) * 8;
    const bf16* cp = ckv + (tok0 + (tid >> 3)) * 256 + 128 + (tid & 7) * 8;
    const bf16* vp = vt + (size_t)(h * 128 + (tid >> 2)) * T + tok0 + (tid & 3) * 8;
    const int kdst = (tid >> 3) * AT_KROW + (tid & 7) * 16, vdst = AT_KB + (tid >> 2) * AT_VROW + (tid & 3) * 16;
#define AT_LOAD(t) do { st[0] = *(const GAS v4u*)(kp); st[1] = *(const GAS v4u*)(kp + 64); st[2] = *(const GAS v4u*)(cp); st[3] = *(const GAS v4u*)(vp); st[4] = *(const GAS v4u*)(vp + 32); \
        kp += 64 * 2048; cp += 64 * 256; vp += 64; } while (0)
#define AT_STORE(buf) do { LAS unsigned char* bb_ = lds + (buf) * (AT_KB + AT_VB); \
        *(LAS v4u*)(bb_ + kdst) = st[0]; *(LAS v4u*)(bb_ + kdst + 128) = st[1]; *(LAS v4u*)(bb_ + kdst + 256) = st[2]; *(LAS v4u*)(bb_ + vdst) = st[3]; *(LAS v4u*)(bb_ + vdst + 64) = st[4]; } while (0)
    AT_LOAD(0); AT_STORE(0);
    __syncthreads();
    for (int t = 0; t < NT; ++t) {
        const int buf = t & 1;
        if (t + 1 < NT) AT_LOAD(t + 1);
        if (64 * t <= q0 + wid * 32 + 31) {
            const LAS unsigned char* kb = lds + buf * (AT_KB + AT_VB) + r32 * AT_KROW + hi * 16;
            f32x16 s0, s1;
#pragma unroll
            for (int i = 0; i < 16; ++i) { s0[i] = 0.f; s1[i] = 0.f; }
#pragma unroll
            for (int s = 0; s < 12; ++s) { const bf16x8 a0 = *(const LAS bf16x8*)(kb + s * 32), a1 = *(const LAS bf16x8*)(kb + 32 * AT_KROW + s * 32);
                s0 = __builtin_amdgcn_mfma_f32_32x32x16_bf16(a0, qf[s], s0, 0, 0, 0); s1 = __builtin_amdgcn_mfma_f32_32x32x16_bf16(a1, qf[s], s1, 0, 0, 0); }
            if (64 * t + 63 > q0 + wid * 32) {
#pragma unroll
                for (int i = 0; i < 16; ++i) { const int key = 64 * t + crow(i, hi); if (key > qrow) s0[i] = -__builtin_inff(); if (key + 32 > qrow) s1[i] = -__builtin_inff(); }
            }
            float mx = s0[0];
#pragma unroll
            for (int i = 1; i < 16; ++i) mx = fmaxf(mx, s0[i]);
#pragma unroll
            for (int i = 0; i < 16; ++i) mx = fmaxf(mx, s1[i]);
            mx = fmaxf(mx, __shfl_xor(mx, 32));
            const float mn = fmaxf(m_run, mx), alpha = __builtin_amdgcn_exp2f(m_run - mn); m_run = mn;
            float ps = 0.f;
#pragma unroll
            for (int i = 0; i < 16; ++i) { s0[i] = __builtin_amdgcn_exp2f(s0[i] - mn); s1[i] = __builtin_amdgcn_exp2f(s1[i] - mn); ps += s0[i] + s1[i]; }
            l_run = l_run * alpha + ps;
#pragma unroll
            for (int d = 0; d < 4; ++d)
#pragma unroll
                for (int i = 0; i < 16; ++i) o[d][i] *= alpha;
            bf16x8 pb[4];
#pragma unroll
            for (int s2 = 0; s2 < 2; ++s2) {
                v4u w0, w1;
                w0.x = cvtpk(s0[8 * s2 + 0], s0[8 * s2 + 1]); w0.y = cvtpk(s0[8 * s2 + 2], s0[8 * s2 + 3]); w0.z = cvtpk(s0[8 * s2 + 4], s0[8 * s2 + 5]); w0.w = cvtpk(s0[8 * s2 + 6], s0[8 * s2 + 7]);
                w1.x = cvtpk(s1[8 * s2 + 0], s1[8 * s2 + 1]); w1.y = cvtpk(s1[8 * s2 + 2], s1[8 * s2 + 3]); w1.z = cvtpk(s1[8 * s2 + 4], s1[8 * s2 + 5]); w1.w = cvtpk(s1[8 * s2 + 6], s1[8 * s2 + 7]);
                pb[s2] = __builtin_bit_cast(bf16x8, w0); pb[2 + s2] = __builtin_bit_cast(bf16x8, w1);
            }
            const LAS unsigned char* vb = lds + buf * (AT_KB + AT_VB) + AT_KB + r32 * AT_VROW + hi * 8;
#pragma unroll
            for (int d = 0; d < 4; ++d)
#pragma unroll
                for (int ks = 0; ks < 4; ++ks) {
                    const s16x4 lo = *(const LAS s16x4*)(vb + d * 32 * AT_VROW + ks * 32), hh = *(const LAS s16x4*)(vb + d * 32 * AT_VROW + ks * 32 + 16);
                    const bf16x8 a = __builtin_shufflevector(lo, hh, 0, 1, 2, 3, 4, 5, 6, 7);
                    o[d] = __builtin_amdgcn_mfma_f32_32x32x16_bf16(a, pb[ks], o[d], 0, 0, 0);
                }
        }
        if (t + 1 < NT) AT_STORE(buf ^ 1);
        __syncthreads();
    }
#undef AT_LOAD
#undef AT_STORE
    const float lt = l_run + __shfl_xor(l_run, 32), inv = 1.0f / lt;
    bf16* op = obuf + tokq * 2048 + h * 128 + 4 * hi;
#pragma unroll
    for (int d = 0; d < 4; ++d)
#pragma unroll
        for (int g = 0; g < 4; ++g) { pg8::u32x2 w; w.x = cvtpk(o[d][4 * g] * inv, o[d][4 * g + 1] * inv); w.y = cvtpk(o[d][4 * g + 2] * inv, o[d][4 * g + 3] * inv);
            *(GAS pg8::u32x2*)(op + 32 * d + 8 * g) = w; }
}

__device__ __forceinline__ int moe_tables(const Args& A, int layer, LAS unsigned char* lds, int tid) {
    LAS int* tstart = (LAS int*)(lds + TAB_TSTART); LAS unsigned char* tile_e = lds + TAB_TILEE;
    const unsigned* cnt = (const unsigned*)(A.ws + WS_CTL) + CW_CNT + layer * NE * 16;
    LAS int* lcn = (LAS int*)(lds + TAB_LCNT);
    if (tid < NE) lcn[tid] = ((int)__hip_atomic_load(cnt + tid * 16, RLX_AGENT) + 255) >> 8;
    __syncthreads();
    if (tid == 0) { int acc = 0; for (int e = 0; e < NE; ++e) { tstart[e] = acc; acc += lcn[e]; } tstart[NE] = acc; }
    __syncthreads();
    if (tid < NE) { const int s = tstart[tid], e2 = tstart[tid + 1]; for (int i = s; i < e2; ++i) tile_e[i] = (unsigned char)tid; }
    __syncthreads();
    return tstart[NE];
}

__device__ __forceinline__ void ln_row(f32x4 (&v)[4], const f32x4 (&g)[4], const f32x4 (&bb)[4]) {
    float s = 0.f;
#pragma unroll
    for (int j = 0; j < 4; ++j) s += (v[j].x + v[j].y) + (v[j].z + v[j].w);
    const float mean = wave_sum(s) * (1.f / D); float s2 = 0.f;
#pragma unroll
    for (int j = 0; j < 4; ++j) { v[j] = v[j] - mean; s2 += (v[j].x * v[j].x + v[j].y * v[j].y) + (v[j].z * v[j].z + v[j].w * v[j].w); }
    const float rstd = 1.f / sqrtf(wave_sum(s2) * (1.f / D) + LN_EPS);
#pragma unroll
    for (int j = 0; j < 4; ++j) v[j] = v[j] * rstd * g[j] + bb[j];
}

#define IN(k) (lo <= (k) && (k) < hi)
#define OPQ() int tid = threadIdx.x; asm volatile("" : "+v"(tid)); const int lane = tid & 63, wave = __builtin_amdgcn_readfirstlane(tid >> 6); (void)lane; (void)wave; OPQW()
#define OPQW() unsigned char* ws = A.ws; asm volatile("" : "+s"(ws)); gu32* ctl = (gu32*)(ws + WS_CTL); bf16* xb = (bf16*)(ws + WS_XB); float* tbuf = (float*)(ws + WS_TBUF); (void)ctl; (void)xb; (void)tbuf
#define SEAM() do { if (A.single) xcd_barrier(bar); } while (0)

template <int layer> __device__ __forceinline__ void run_layer(const Args& A, LAS unsigned char* lds, const XcdBarrier& bar, const int G, const int bx, const int vcu, const int lo, const int hi) {
        const int sb = 1 + layer * 16;
        const float* xres = (layer == 0) ? A.x : A.out;
        if constexpr (layer < N_A) {
            if (IN(sb + 0)) {
                OPQW();
                pg8::Gemm g{xb, (const bf16*)(ws + WS_HGWIN) + (size_t)layer * 4096 * 1024, T, 4096, 1024}; pg8::StaticOrder S; S.init(T, 4096, G, bx);
                pg8::EpiHgIn E{(bf16*)(ws + WS_BIG), (const float*)(ws + WS_LBTAB) + layer * 1024};
                pg8::gemm_phase<pg8::EpiHgIn, pg8::StaticOrder, true, true>(lds + RING_OFF, g, S, E); SEAM();
            }
            if (IN(sb + 1)) {
                OPQ();
                for (int u = vcu; u < BATCH * HGH; u += G) hg_scan_unit(A, layer, u, lds, tid);
                SEAM();
            }
        } else {
            const int j = layer - N_A;
            if constexpr (layer == N_A) {
                if (IN(sb + 0)) {
                OPQW();
                    pg8::Gemm g{xb, (const bf16*)(ws + WS_KVA), T, 256, 1024}; pg8::StaticOrder S; S.init(T, 256, G, bx);
                    pg8::EpiKva E{(bf16*)(ws + WS_CKV), (const float*)(ws + WS_ROPE)};
                    pg8::gemm_phase<pg8::EpiKva, pg8::StaticOrder, true, true>(lds + RING_OFF, g, S, E); SEAM();
                }
                if (IN(sb + 1)) {
                OPQ();
                    bf16* ckv = (bf16*)(ws + WS_CKV); const int sub = lane & 15; const f32x4 g0 = *(const f32x4*)(A.kv_norm + sub * 8), g1 = *(const f32x4*)(A.kv_norm + sub * 8 + 4);
                    for (int r = (vcu * NTHR + tid) >> 4; r < T; r += (G * NTHR) >> 4) { GAS v4u* p = (GAS v4u*)(ckv + (size_t)r * 256 + sub * 8); const v4u w = *p;
                        float f[8] = {bflo(w.x), bfhi(w.x), bflo(w.y), bfhi(w.y), bflo(w.z), bfhi(w.z), bflo(w.w), bfhi(w.w)}; float ss = 0.f;
#pragma unroll
                        for (int i = 0; i < 8; ++i) ss += f[i] * f[i];
                        ss += __shfl_xor(ss, 1); ss += __shfl_xor(ss, 2); ss += __shfl_xor(ss, 4); ss += __shfl_xor(ss, 8);
                        const float rs = 1.0f / sqrtf(ss * (1.0f / 128.0f) + RMS_EPS);
                        *p = (v4u){cvtpk(f[0] * rs * g0[0], f[1] * rs * g0[1]), cvtpk(f[2] * rs * g0[2], f[3] * rs * g0[3]), cvtpk(f[4] * rs * g1[0], f[5] * rs * g1[1]), cvtpk(f[6] * rs * g1[2], f[7] * rs * g1[3])}; }
                    SEAM();
                }
            }
            for (int gi = 0; gi < 3; ++gi) {
                if (gi < 2 && layer != N_A) continue;
                if (IN(sb + 2 + gi)) {
                OPQW();
                    pg8::Gemm g; pg8::StaticOrder S; pg8::EpiPlain E;
                    if (gi == 0) { g = pg8::Gemm{(const bf16*)(ws + WS_CKV), (const bf16*)(ws + WS_KVB), T, 2048, 256}; S.init(T, 2048, G, bx); E = pg8::EpiPlain{(bf16*)(ws + WS_KN), 2048, 1.0f}; }
                    else if (gi == 1) { g = pg8::Gemm{(const bf16*)(ws + WS_KVB) + (size_t)2048 * 256, (const bf16*)(ws + WS_CKV), 2048, T, 256}; S.init(2048, T, G, bx); E = pg8::EpiPlain{(bf16*)(ws + WS_VT), T, 1.0f}; }
                    else { g = pg8::Gemm{xb, (const bf16*)(ws + WS_DQ) + (size_t)j * 256 * 1024, T, 256, 1024}; S.init(T, 256, G, bx); E = pg8::EpiPlain{(bf16*)(ws + WS_CQ), 256, 1.0f}; }
                    pg8::gemm_phase<pg8::EpiPlain, pg8::StaticOrder, true, true>(lds + RING_OFF, g, S, E); SEAM();
                }
            }
            if (IN(sb + 5)) {
                OPQ();
                bf16* cq = (bf16*)(ws + WS_CQ); const int sub = lane & 31; const f32x4 g0 = *(const f32x4*)(A.mla_q_norm + j * 256 + sub * 8), g1 = *(const f32x4*)(A.mla_q_norm + j * 256 + sub * 8 + 4);
                for (int r = (vcu * NTHR + tid) >> 5; r < T; r += (G * NTHR) >> 5) { GAS v4u* p = (GAS v4u*)(cq + (size_t)r * 256 + sub * 8); const v4u w = *p;
                    float f[8] = {bflo(w.x), bfhi(w.x), bflo(w.y), bfhi(w.y), bflo(w.z), bfhi(w.z), bflo(w.w), bfhi(w.w)}; float ss = 0.f;
#pragma unroll
                    for (int i = 0; i < 8; ++i) ss += f[i] * f[i];
                    ss += __shfl_xor(ss, 1); ss += __shfl_xor(ss, 2); ss += __shfl_xor(ss, 4); ss += __shfl_xor(ss, 8); ss += __shfl_xor(ss, 16);
                    const float rs = 1.0f / sqrtf(ss * (1.0f / 256.0f) + RMS_EPS);
                    *p = (v4u){cvtpk(f[0] * rs * g0[0], f[1] * rs * g0[1]), cvtpk(f[2] * rs * g0[2], f[3] * rs * g0[3]), cvtpk(f[4] * rs * g1[0], f[5] * rs * g1[1]), cvtpk(f[6] * rs * g1[2], f[7] * rs * g1[3])}; }
                SEAM();
            }
            if (IN(sb + 6)) {
                OPQW();
                pg8::Gemm g{(const bf16*)(ws + WS_CQ), (const bf16*)(ws + WS_UQ) + (size_t)j * 3072 * 256, T, 3072, 256}; pg8::StaticOrder S; S.init(T, 3072, G, bx);
                pg8::EpiUq E{(bf16*)(ws + WS_BIG), (const float*)(ws + WS_ROPE), QSCALE};
                pg8::gemm_phase<pg8::EpiUq, pg8::StaticOrder, true, true>(lds + RING_OFF, g, S, E); SEAM();
            }
            if (IN(sb + 7)) {
                OPQ();
                for (int u = vcu; u < BATCH * MH; u += G) { const int b = u / MH, h = u % MH; for (int qb = 7; qb >= 0; --qb) attn_unit(A, b, h, qb, lds, tid); }
                SEAM();
            }
        }
        if (IN(sb + 8)) {
                OPQW();
            pg8::Gemm g; if (layer < N_A) g = pg8::Gemm{(const bf16*)(ws + WS_ABUF), (const bf16*)(ws + WS_HGWO) + (size_t)layer * 1024 * 1024, T, 1024, 1024};
            else g = pg8::Gemm{(const bf16*)(ws + WS_ABUF), (const bf16*)(ws + WS_MWO) + (size_t)(layer - N_A) * 1024 * 2048, T, 1024, 2048};
            pg8::StaticOrder S; S.init(T, 1024, G, bx); pg8::EpiRes E{xres, tbuf, DN_ALPHA};
            pg8::gemm_phase<pg8::EpiRes, pg8::StaticOrder, true, true>(lds + RING_OFF, g, S, E); SEAM();
        }
        if (IN(sb + 9)) {
                OPQ();
            LAS float* Wl = (LAS float*)lds;
            const float* rw = A.router_w + (size_t)layer * D * NE;
            for (int i = tid; i < D * NE; i += NTHR) Wl[(i & 31) * 1024 + (i >> 5)] = rw[i];
            LAS int* lcnt = (LAS int*)(lds + TAB_LCNT); LAS int* lbase = (LAS int*)(lds + TAB_LBASE); LAS int* a_e = (LAS int*)(lds + TAB_AE); LAS int* a_rank = (LAS int*)(lds + TAB_ARANK);
            if (tid < NE) lcnt[tid] = 0;
            __syncthreads();
            f32x4 gv[4], bv[4];
#pragma unroll
            for (int jj = 0; jj < 4; ++jj) { gv[jj] = *(const f32x4*)(A.ln_g + (size_t)(layer * 2 + 0) * D + 4 * lane + 256 * jj); bv[jj] = *(const f32x4*)(A.ln_b + (size_t)(layer * 2 + 0) * D + 4 * lane + 256 * jj); }
            const float rbias = (lane < NE) ? A.router_b[layer * NE + lane] : 0.f;
            const int chunk = T / G, wbase = vcu * chunk;
            for (int p0 = wave * 4; p0 < chunk; p0 += NWAVES * 4) {
                f32x4 xv[4][4];
#pragma unroll
                for (int tt = 0; tt < 4; ++tt) { const size_t m = (size_t)(wbase + p0 + tt);
#pragma unroll
                    for (int jj = 0; jj < 4; ++jj) xv[tt][jj] = *(const GAS f32x4*)(tbuf + m * D + 4 * lane + 256 * jj);
                    ln_row(xv[tt], gv, bv);
#pragma unroll
                    for (int jj = 0; jj < 4; ++jj) { *(GAS f32x4*)(A.out + m * D + 4 * lane + 256 * jj) = xv[tt][jj];
                        *(GAS unsigned long long*)(xb + m * D + 4 * lane + 256 * jj) = (unsigned long long)cvtpk(xv[tt][jj].x, xv[tt][jj].y) | ((unsigned long long)cvtpk(xv[tt][jj].z, xv[tt][jj].w) << 32); } }
                float myl[4] = {-__builtin_inff(), -__builtin_inff(), -__builtin_inff(), -__builtin_inff()};
                for (int e = 0; e < NE; ++e) {
                    float pr[4] = {0.f, 0.f, 0.f, 0.f};
#pragma unroll
                    for (int jj = 0; jj < 4; ++jj) { const f32x4 w = *(const LAS f32x4*)(Wl + e * 1024 + 4 * lane + 256 * jj);
#pragma unroll
                        for (int tt = 0; tt < 4; ++tt) pr[tt] += (xv[tt][jj].x * w.x + xv[tt][jj].y * w.y) + (xv[tt][jj].z * w.z + xv[tt][jj].w * w.w); }
#pragma unroll
                    for (int tt = 0; tt < 4; ++tt) { const float s = wave_sum(pr[tt]); if (lane == e) myl[tt] = s + rbias; }
                }
#pragma unroll
                for (int tt = 0; tt < 4; ++tt) {
                    float val = myl[tt]; float tv[4]; int te[4];
#pragma unroll
                    for (int k = 0; k < 4; ++k) { float bvv = val; int bi = lane;
#pragma unroll
                        for (int off = 32; off >= 1; off >>= 1) { const float ov = __shfl_xor(bvv, off); const int oi = __shfl_xor(bi, off); if (ov > bvv || (ov == bvv && oi < bi)) { bvv = ov; bi = oi; } }
                        tv[k] = bvv; te[k] = bi; if (lane == bi) val = -__builtin_inff(); }
                    const float e1 = __expf(tv[1] - tv[0]), e2 = __expf(tv[2] - tv[0]), e3 = __expf(tv[3] - tv[0]); const float inv = 1.0f / (1.0f + e1 + e2 + e3);
                    if (lane < 4) { const int ek = lane == 0 ? te[0] : lane == 1 ? te[1] : lane == 2 ? te[2] : te[3]; const float gk = (lane == 0 ? 1.0f : lane == 1 ? e1 : lane == 2 ? e2 : e3) * inv;
                        const int la = (p0 + tt) * 4 + lane; const size_t a = (size_t)(wbase + p0 + tt) * 4 + lane;
                        ((int*)(ws + WS_SELE))[a] = ek; ((float*)(ws + WS_SELG))[a] = gk;
                        a_e[la] = ek; a_rank[la] = __hip_atomic_fetch_add(&lcnt[ek], 1, __ATOMIC_RELAXED, __HIP_MEMORY_SCOPE_WORKGROUP); }
                }
            }
            __syncthreads();
            if (tid < NE) lbase[tid] = (int)__hip_atomic_fetch_add((unsigned*)(ctl + CW_CNT + layer * NE * 16 + tid * 16), (unsigned)lcnt[tid], RLX_AGENT);
            __syncthreads();
            for (int la = tid; la < chunk * 4; la += NTHR) ((int*)(ws + WS_APOS))[(size_t)wbase * 4 + la] = lbase[a_e[la]] + a_rank[la];
            __syncthreads();
            SEAM();
        }
        if (IN(sb + 10)) {
                OPQ();
            moe_tables(A, layer, lds, tid);
            LAS int* tstart = (LAS int*)(lds + TAB_TSTART);
            const int chunk = T / G; const size_t abase = (size_t)vcu * chunk * 4;
            const int* sele = (const int*)(ws + WS_SELE); const float* selg = (const float*)(ws + WS_SELG); const int* apos = (const int*)(ws + WS_APOS);
            int* rslot = (int*)(ws + WS_RSLOT); float* rgate = (float*)(ws + WS_RGATE); bf16* xs = (bf16*)(ws + WS_BIG);
            for (int la = wave; la < chunk * 4; la += NWAVES) { const size_t a = abase + la; const int e = sele[a]; const int row = tstart[e] * 256 + apos[a];
                if (lane == 0) { rslot[row] = (int)a; rgate[row] = selg[a]; }
                const GAS v4u* src = (const GAS v4u*)(xb + (a >> 2) * D) + lane; GAS v4u* dst = (GAS v4u*)(xs + (size_t)row * D) + lane;
                const v4u w0 = src[0], w1 = src[64]; dst[0] = w0; dst[64] = w1; }
            const unsigned* cnt = (const unsigned*)(ws + WS_CTL) + CW_CNT + layer * NE * 16;
            for (int e = vcu; e < NE; e += G) { const int c = (int)__hip_atomic_load(cnt + e * 16, RLX_AGENT), r0 = tstart[e] * 256 + c, r1 = tstart[e + 1] * 256;
                for (int r = r0 + tid; r < r1; r += NTHR) { rslot[r] = -1; rgate[r] = 0.f; } }
            __syncthreads();
            SEAM();
        }
        if (IN(sb + 11)) {
                OPQ();
            const int nM = moe_tables(A, layer, lds, tid);
            pg8::Gemm g{(const bf16*)(ws + WS_BIG), (const bf16*)(ws + WS_W1) + (size_t)layer * NE * 2048 * 1024, nM * 256, 2048, 1024};
            pg8::MoeOrder S; S.init(nM * 256, 2048, G, bx); S.tile_e = lds + TAB_TILEE;
            pg8::EpiMoe1 E{(bf16*)(ws + WS_ABUF), A.moe_b1 + (size_t)layer * NE * 2048};
            pg8::gemm_phase<pg8::EpiMoe1, pg8::MoeOrder, true, true>(lds + RING_OFF, g, S, E); SEAM();
        }
        if (IN(sb + 12)) {
                OPQ();
            const int nM = moe_tables(A, layer, lds, tid);
            pg8::Gemm g{(const bf16*)(ws + WS_ABUF), (const bf16*)(ws + WS_W2) + (size_t)layer * NE * 1024 * 1024, nM * 256, 1024, 1024};
            pg8::MoeOrder S; S.init(nM * 256, 1024, G, bx); S.tile_e = lds + TAB_TILEE;
            pg8::EpiMoe2 E{(bf16*)(ws + WS_BIG), A.moe_b2 + (size_t)layer * NE * 1024, (const int*)(ws + WS_RSLOT), (const float*)(ws + WS_RGATE)};
            pg8::gemm_phase<pg8::EpiMoe2, pg8::MoeOrder, true, true>(lds + RING_OFF, g, S, E); SEAM();
        }
        if (IN(sb + 13)) {
                OPQ();
            const bf16* ybuf = (const bf16*)(ws + WS_BIG);
            f32x4 gv[4], bv[4];
#pragma unroll
            for (int jj = 0; jj < 4; ++jj) { gv[jj] = *(const f32x4*)(A.ln_g + (size_t)(layer * 2 + 1) * D + 4 * lane + 256 * jj); bv[jj] = *(const f32x4*)(A.ln_b + (size_t)(layer * 2 + 1) * D + 4 * lane + 256 * jj); }
            for (int m = vcu * NWAVES + wave; m < T; m += G * NWAVES) {
                f32x4 v[4];
#pragma unroll
                for (int jj = 0; jj < 4; ++jj) { v[jj] = *(const GAS f32x4*)(A.out + (size_t)m * D + 4 * lane + 256 * jj) * DN_ALPHA;
#pragma unroll
                    for (int k = 0; k < 4; ++k) { const unsigned long long w = *(const GAS unsigned long long*)(ybuf + ((size_t)m * 4 + k) * D + 4 * lane + 256 * jj); const unsigned wl = (unsigned)w, wh = (unsigned)(w >> 32);
                        v[jj].x += bflo(wl); v[jj].y += bfhi(wl); v[jj].z += bflo(wh); v[jj].w += bfhi(wh); } }
                ln_row(v, gv, bv);
#pragma unroll
                for (int jj = 0; jj < 4; ++jj) { *(GAS f32x4*)(A.out + (size_t)m * D + 4 * lane + 256 * jj) = v[jj];
                    *(GAS unsigned long long*)(xb + (size_t)m * D + 4 * lane + 256 * jj) = (unsigned long long)cvtpk(v[jj].x, v[jj].y) | ((unsigned long long)cvtpk(v[jj].z, v[jj].w) << 32); }
            }
            if (layer + 1 < DEPTH) SEAM();
        }
}

__global__ void __launch_bounds__(NTHR, 2) yoco_fwd(Args A) {
    extern __shared__ __attribute__((aligned(16))) unsigned char lds_raw[];
    LAS unsigned char* lds = (LAS unsigned char*)lds_raw;
    volatile LAS unsigned* MISC = (volatile LAS unsigned*)(lds + MISC_OFF);
    const int tid0 = threadIdx.x;
    const int G = gridDim.x; const int bx = blockIdx.x; const int vcu = (G % 8 == 0) ? (bx % 8) * (G / 8) + bx / 8 : bx;
    gu32* ctl0 = (gu32*)(A.ws + WS_CTL);
    for (int u = tid0; u < (TAB_OFF - LDSCTL_OFF) / 4; u += NTHR) ((LAS unsigned*)(lds + LDSCTL_OFF))[u] = 0u;
    __syncthreads();
    XcdBarrier bar; bar.bar = (unsigned*)(ctl0 + CW_BAR); bar.x = 0; bar.st = nullptr;
    if (A.single) bar = xcd_barrier_post((unsigned*)(ctl0 + CW_BAR), MISC + 8);
    const int lo = A.st_lo, hi = A.st_hi;

    if (IN(0)) { OPQ(); p0_prologue(A, lds, vcu, G, wave, lane, tid); SEAM(); }

    run_layer<0>(A, lds, bar, G, bx, vcu, lo, hi);
    run_layer<1>(A, lds, bar, G, bx, vcu, lo, hi);
    run_layer<2>(A, lds, bar, G, bx, vcu, lo, hi);
    run_layer<3>(A, lds, bar, G, bx, vcu, lo, hi);
#undef IN
#undef SEAM
}

extern "C" void kernel_launch(void* const* d_in, const int* in_sizes, int n_in, void* d_out, int out_size, void* d_ws, size_t ws_size, hipStream_t stream) {
    static int grid = 0;
    if (grid == 0) {
        if (n_in != 21 || in_sizes[0] != T * D || out_size != T * D || ws_size < WS_END) { fprintf(stderr, "kernel_launch: unexpected shapes (n_in %d, in0 %d, out %d, ws %zu)\n", n_in, n_in > 0 ? in_sizes[0] : -1, out_size, ws_size); grid = -1; return; }
        int dev = 0, cus = 0, per_cu = 0;
        if (hipGetDevice(&dev) != hipSuccess || hipDeviceGetAttribute(&cus, hipDeviceAttributeMultiprocessorCount, dev) != hipSuccess) { grid = -1; return; }
        if (hipFuncSetAttribute((const void*)yoco_fwd, hipFuncAttributeMaxDynamicSharedMemorySize, LDS_BYTES) != hipSuccess) { fprintf(stderr, "kernel_launch: hipFuncSetAttribute failed\n"); grid = -1; return; }
        if (hipOccupancyMaxActiveBlocksPerMultiprocessor(&per_cu, (const void*)yoco_fwd, NTHR, LDS_BYTES) != hipSuccess || per_cu < 1) fprintf(stderr, "kernel_launch: occupancy query reports %d\n", per_cu);
        (void)hipGetLastError();
        grid = cus;
        if (grid != 256) { fprintf(stderr, "kernel_launch: built for 256 CUs, device has %d\n", cus); grid = -1; return; }
    }
    if (grid < 0) return;
    if (hipMemsetAsync((char*)d_ws + WS_CTL, 0, CTL_ZERO_BYTES, stream) != hipSuccess) return;
    Args a{};
    a.x = (const float*)d_in[0]; a.pos = (const int*)d_in[1]; a.ln_g = (const float*)d_in[2]; a.ln_b = (const float*)d_in[3]; a.hg_w_in = (const float*)d_in[4]; a.hg_lb = (const float*)d_in[5];
    a.hg_gnorm = (const float*)d_in[6]; a.hg_w_o = (const float*)d_in[7]; a.mla_w_dq = (const float*)d_in[8]; a.mla_q_norm = (const float*)d_in[9]; a.mla_w_uq = (const float*)d_in[10]; a.mla_w_o = (const float*)d_in[11];
    a.kv_w_a = (const float*)d_in[12]; a.kv_norm = (const float*)d_in[13]; a.kv_w_b = (const float*)d_in[14]; a.router_w = (const float*)d_in[15]; a.router_b = (const float*)d_in[16];
    a.moe_w1 = (const float*)d_in[17]; a.moe_b1 = (const float*)d_in[18]; a.moe_w2 = (const float*)d_in[19]; a.moe_b2 = (const float*)d_in[20];
    a.out = (float*)d_out; a.ws = (unsigned char*)d_ws; a.pad = 0;
#if MK_SINGLE
    a.st_lo = 0; a.st_hi = 1 << 20; a.single = 1;
    hipLaunchKernelGGL(yoco_fwd, dim3(grid), dim3(NTHR), LDS_BYTES, stream, a);
#else
    a.single = 0;
    for (int st = 0; st < 1 + DEPTH * 16; ++st) {
        if (st > 0) { const int layer = (st - 1) / 16, loc = (st - 1) % 16; if (loc > 13) continue;
            if (layer < N_A) { if (loc >= 2 && loc <= 7) continue; }
            else { if (layer != N_A && loc <= 3) continue; } }
        a.st_lo = st; a.st_hi = st + 1;
        hipLaunchKernelGGL(yoco_fwd, dim3(grid), dim3(NTHR), LDS_BYTES, stream, a);
    }
#endif
}
```

```cpp
#include <hip/hip_runtime.h>
#include <cstdio>
#include <cstdint>
#ifndef MK_SINGLE
#define MK_SINGLE 1
#endif
#ifndef MOE_WGM
#define MOE_WGM 8
#endif
#ifndef REP_MASK
#define REP_MASK 0
#define REP_LAYER 0
#endif
__device__ __forceinline__ int tid_of(int wave_s) { int l; asm volatile("v_mbcnt_lo_u32_b32 %0, -1, 0\n\tv_mbcnt_hi_u32_b32 %0, -1, %0" : "=v"(l)); return wave_s * 64 + l; }
namespace pg8 {

#define PG8_LAS __attribute__((address_space(3)))
typedef unsigned short bf16_t;
typedef short bf16x8 __attribute__((ext_vector_type(8)));
typedef float f32x4 __attribute__((ext_vector_type(4)));
typedef unsigned u32x4 __attribute__((ext_vector_type(4)));
constexpr float W1_SC = 128.0f, W2_SC = 256.0f, H_SC = 4.0f, HIN_SC = 128.0f, MWO_SC = 256.0f, OB_SC = 16.0f, Q_SC = 64.0f, K_SC = 16.0f;
typedef int i32x4 __attribute__((ext_vector_type(4))); typedef int i32x8 __attribute__((ext_vector_type(8)));
constexpr int BM = 256, BK = 64, HALF = 128, HTB = HALF * BK * 2  , STAGE_BYTES = 8 * HTB, NXCD = 8, WGM = 8;

__host__ __device__ __forceinline__ int lds_byte(int r, int c) { const int st = (r >> 4) * 2 + (c >> 5), rr = r & 15, cc = c & 31, ob = rr * 64 + cc * 2; return st * 1024 + (ob ^ (((ob >> 9) & 1) << 5)); }
__host__ __device__ __forceinline__ void stage_rc(int b, int& R, int& C) { const int st = b / 1024, sb = b % 1024, swz = sb ^ (((sb >> 9) & 1) << 5); R = (st >> 1) * 16 + swz / 64; C = (st & 1) * 32 + (swz % 64) / 2; }
__host__ __device__ __forceinline__ int perm32(int rho) { const int n = rho >> 4, i = rho & 15; return 8 * (i >> 2) + 4 * n + (i & 3); }

#ifndef KROT
#define KROT 0
#endif
struct Unit { int pm, pn, pb, e, g0, gc, kr; };
struct Gemm { const bf16_t* A; const bf16_t* Bt; int M, N, K; };

struct StaticOrder {
    int rev = 0; int nM, nN, nwg, G, c, wgm;
    __host__ __device__ void init(int M, int N, int G_, int c_, int wgm_ = WGM) { nM = M / BM; nN = N / BM; nwg = nM * nN; G = G_; c = c_; wgm = wgm_; }
    __host__ __device__ bool next(int i, Unit& u) const {
        const long L = (long)i * G + c; if (L >= nwg) return false;
        int wgid = (int)L; { const int q = nwg / NXCD, r = nwg % NXCD, xcd = wgid % NXCD; int off = wgid / NXCD; if (rev) off = (xcd < r ? q : q - 1) - off;     wgid = (xcd < r ? xcd * (q + 1) : r * (q + 1) + (xcd - r) * q) + off; }
        const int nig = wgm * nN, gid = wgid / nig, rem = wgid - gid * nig, fm = gid * wgm, gsz = (nM - fm) < wgm ? (nM - fm) : wgm;
        if (gsz == 8) { u.pm = fm + (rem & 7); u.pn = rem >> 3; } else { u.pm = fm + (rem % gsz); u.pn = rem / gsz; }
        u.pb = u.pn; u.e = 0; u.g0 = 0; u.gc = 0; u.kr = KROT ? ((u.pm + u.pn) & 3) : 0; return true;
    }
    __device__ __forceinline__ void a_ready(const Unit&) const {}
    __device__ __forceinline__ void done(const Unit&) const {}
};


__device__ __forceinline__ unsigned cvt_pk_bf16(float lo, float hi) { unsigned r; asm volatile("v_cvt_pk_bf16_f32 %0, %1, %2" : "=v"(r) : "v"(lo), "v"(hi)); return r; }
typedef unsigned u32x2 __attribute__((ext_vector_type(2)));
#define PG8_GAS __attribute__((address_space(1)))
__device__ __forceinline__ float sigmoidf_(float v) { return __builtin_amdgcn_rcpf(1.0f + __expf(-v)); }
__device__ __forceinline__ float siluf_(float v) { return v * sigmoidf_(v); }
__device__ __forceinline__ u32x4 pack8(const f32x4 v0, const f32x4 v1) { u32x4 w; w.x = cvt_pk_bf16(v0[0], v0[1]); w.y = cvt_pk_bf16(v0[2], v0[3]); w.z = cvt_pk_bf16(v1[0], v1[1]); w.w = cvt_pk_bf16(v1[2], v1[3]); return w; }

struct EpiPlain {
    static constexpr bool PERM = true, AFTER_DRAIN = false, PROBE_TWICE = false, LDS_PARAMS = false, PERM2 = false, FP8 = false, KT1 = true, SWAP12 = false;
    bf16_t* O; int ldc; float sc;
    __device__ __forceinline__ void operator()(const f32x4 (&acc)[2][2][4][2], const Unit& u, int wr, int wc, int fr, int fq) const {
        const int row0 = u.pm * BM + wr * 64 + fr, col0 = u.pn * BM + wc * 32 + 8 * fq;
#pragma unroll
        for (int ai = 0; ai < 2; ++ai)
#pragma unroll
            for (int m = 0; m < 4; ++m) { bf16_t* rowp = O + (size_t)(row0 + ai * HALF + m * 16) * ldc + col0;
#pragma unroll
                for (int bj = 0; bj < 2; ++bj) *(PG8_GAS u32x4*)(rowp + bj * HALF) = pack8(acc[ai][bj][m][0] * sc, acc[ai][bj][m][1] * sc); }
    }
};
struct EpiHgIn {
    static constexpr bool PERM = true, AFTER_DRAIN = false, PROBE_TWICE = false, LDS_PARAMS = false, PERM2 = false, FP8 = true, KT1 = true, SWAP12 = false;
    bf16_t* O; const float* lb;
    __device__ __forceinline__ void operator()(const f32x4 (&acc)[2][2][4][2], const Unit& u, int wr, int wc, int fr, int fq) const {
        const int row0 = u.pm * BM + wr * 64 + fr, col0 = u.pn * BM + wc * 32 + 8 * fq, kind = u.pn >> 2, ch0 = (u.pn & 3) * BM + wc * 32 + 8 * fq;
        f32x4 lbv[2][2];
#pragma unroll
        for (int bj = 0; bj < 2; ++bj)
#pragma unroll
            for (int n = 0; n < 2; ++n) lbv[bj][n] = (kind == 1) ? *(const PG8_GAS f32x4*)(lb + ch0 + bj * HALF + 4 * n) : (f32x4){0.f, 0.f, 0.f, 0.f};
#pragma unroll
        for (int ai = 0; ai < 2; ++ai)
#pragma unroll
            for (int m = 0; m < 4; ++m) { bf16_t* rowp = O + ((size_t)((u.pm * 16 + ai * 8 + wr * 4 + m) * 128 + u.pn * 8 + wc) * 512 + fr * 32 + 8 * fq);
#pragma unroll
                for (int bj = 0; bj < 2; ++bj) { f32x4 v[2] = {acc[ai][bj][m][0] * (1.0f / HIN_SC), acc[ai][bj][m][1] * (1.0f / HIN_SC)};
                    if (kind == 0 || kind == 3) {
#pragma unroll
                        for (int n = 0; n < 2; ++n)
#pragma unroll
                            for (int j = 0; j < 4; ++j) v[n][j] = siluf_(v[n][j]);
                    } else if (kind == 1) {
#pragma unroll
                        for (int n = 0; n < 2; ++n)
#pragma unroll
                            for (int j = 0; j < 4; ++j) { const float l = lbv[bj][n][j]; v[n][j] = __log2f(l + (1.0f - l) * sigmoidf_(v[n][j])); }
                    }
                    *(PG8_GAS u32x4*)(rowp + bj * 4 * 512) = pack8(v[0], v[1]); } }
    }
};
template <bool F8> struct EpiResT {
    static constexpr bool PERM = true, AFTER_DRAIN = false, PROBE_TWICE = false, LDS_PARAMS = false, PERM2 = false, FP8 = F8, KT1 = true, SWAP12 = false;
    const bf16_t* res; bf16_t* out; float alpha, sc;
    __device__ __forceinline__ void operator()(const f32x4 (&acc)[2][2][4][2], const Unit& u, int wr, int wc, int fr, int fq) const {
        const int row0 = u.pm * BM + wr * 64 + fr, col0 = u.pn * BM + wc * 32 + 8 * fq;
        u32x4 rv[2][4][2];
#pragma unroll
        for (int ai = 0; ai < 2; ++ai)
#pragma unroll
            for (int m = 0; m < 4; ++m)
#pragma unroll
                for (int bj = 0; bj < 2; ++bj) rv[ai][m][bj] = *(const PG8_GAS u32x4*)(res + (size_t)(row0 + ai * HALF + m * 16) * 1024 + col0 + bj * HALF);
#pragma unroll
        for (int ai = 0; ai < 2; ++ai)
#pragma unroll
            for (int m = 0; m < 4; ++m) { const size_t off = (size_t)(row0 + ai * HALF + m * 16) * 1024 + col0;
#pragma unroll
                for (int bj = 0; bj < 2; ++bj) { const u32x4 r = rv[ai][m][bj];
                    const f32x4 r0 = {__builtin_bit_cast(float, r.x << 16), __builtin_bit_cast(float, r.x & 0xffff0000u), __builtin_bit_cast(float, r.y << 16), __builtin_bit_cast(float, r.y & 0xffff0000u)};
                    const f32x4 r1 = {__builtin_bit_cast(float, r.z << 16), __builtin_bit_cast(float, r.z & 0xffff0000u), __builtin_bit_cast(float, r.w << 16), __builtin_bit_cast(float, r.w & 0xffff0000u)};
                    if constexpr (F8) *(PG8_GAS u32x4*)(out + off + bj * HALF) = pack8(r0 * alpha + acc[ai][bj][m][0] * sc, r1 * alpha + acc[ai][bj][m][1] * sc);
                    else *(PG8_GAS u32x4*)(out + off + bj * HALF) = pack8(r0 * alpha + acc[ai][bj][m][0], r1 * alpha + acc[ai][bj][m][1]); } }
    }
};
__device__ __forceinline__ void rope8(f32x4& v0, f32x4& v1, const float* cs) {
    const f32x4 c0 = *(const PG8_GAS f32x4*)cs, c1 = *(const PG8_GAS f32x4*)(cs + 4);
    const float a0 = v0[0], b0 = v0[1], a1 = v0[2], b1 = v0[3], a2 = v1[0], b2 = v1[1], a3 = v1[2], b3 = v1[3];
    v0[0] = a0 * c0[0] - b0 * c0[1]; v0[1] = a0 * c0[1] + b0 * c0[0]; v0[2] = a1 * c0[2] - b1 * c0[3]; v0[3] = a1 * c0[3] + b1 * c0[2];
    v1[0] = a2 * c1[0] - b2 * c1[1]; v1[1] = a2 * c1[1] + b2 * c1[0]; v1[2] = a3 * c1[2] - b3 * c1[3]; v1[3] = a3 * c1[3] + b3 * c1[2];
}
struct EpiKva {
    static constexpr bool PERM = true, AFTER_DRAIN = false, PROBE_TWICE = false, LDS_PARAMS = false, PERM2 = false, FP8 = false, KT1 = true, SWAP12 = false;
    bf16_t* O; const float* rope;
    __device__ __forceinline__ void operator()(const f32x4 (&acc)[2][2][4][2], const Unit& u, int wr, int wc, int fr, int fq) const {
        const int row0 = u.pm * BM + wr * 64 + fr, col0 = wc * 32 + 8 * fq;
#pragma unroll
        for (int ai = 0; ai < 2; ++ai)
#pragma unroll
            for (int m = 0; m < 4; ++m) { const int row = row0 + ai * HALF + m * 16; bf16_t* rowp = O + (size_t)row * 256 + col0;
                *(PG8_GAS u32x4*)(rowp) = pack8(acc[ai][0][m][0], acc[ai][0][m][1]);
                f32x4 v0 = acc[ai][1][m][0], v1 = acc[ai][1][m][1];
                if (wc < 2) rope8(v0, v1, rope + (size_t)row * 64 + (wc * 16 + 4 * fq) * 2);
                else { v0 = (f32x4){0.f, 0.f, 0.f, 0.f}; v1 = v0; }
                *(PG8_GAS u32x4*)(rowp + HALF) = pack8(v0, v1); }
    }
};
struct EpiUq {
    static constexpr bool PERM = true, AFTER_DRAIN = false, PROBE_TWICE = false, LDS_PARAMS = false, PERM2 = true, FP8 = false, KT1 = true, SWAP12 = false;
    bf16_t* O; const float* rope; float sc;
    __device__ __forceinline__ void operator()(const f32x4 (&acc)[2][2][4][2], const Unit& u, int wr, int wc, int fr, int fq) const {
        const int row0 = u.pm * BM + wr * 64 + fr, r = (u.pn * BM + wc * 64 + 16 * fq) % 192;
        const PG8_GAS float* __restrict__ rp = (const PG8_GAS float*)rope; PG8_GAS bf16_t* __restrict__ op = (PG8_GAS bf16_t*)O;
#pragma unroll
        for (int ai = 0; ai < 2; ++ai)
#pragma unroll
            for (int m = 0; m < 4; ++m) { const int row = row0 + ai * HALF + m * 16; PG8_GAS unsigned char* rowp = (PG8_GAS unsigned char*)op + ((size_t)((u.pm * 16 + ai * 8 + wr * 4 + m) * 96 + u.pn * 8 + 2 * wc + (fq >> 1)) * 512 + fr * 32 + 16 * (fq & 1));
                unsigned wq[4];
#pragma unroll
                for (int bj = 0; bj < 2; ++bj) { f32x4 v0 = acc[ai][bj][m][0] * sc, v1 = acc[ai][bj][m][1] * sc;
                    if (r >= 128) { const PG8_GAS float* cs = rp + (size_t)row * 64 + (r - 128) + 8 * bj; const f32x4 c0 = *(const PG8_GAS f32x4*)cs, c1 = *(const PG8_GAS f32x4*)(cs + 4);
                        const float a0 = v0[0], b0 = v0[1], a1 = v0[2], b1 = v0[3], a2 = v1[0], b2 = v1[1], a3 = v1[2], b3 = v1[3];
                        v0[0] = a0 * c0[0] - b0 * c0[1]; v0[1] = a0 * c0[1] + b0 * c0[0]; v0[2] = a1 * c0[2] - b1 * c0[3]; v0[3] = a1 * c0[3] + b1 * c0[2];
                        v1[0] = a2 * c1[0] - b2 * c1[1]; v1[1] = a2 * c1[1] + b2 * c1[0]; v1[2] = a3 * c1[2] - b3 * c1[3]; v1[3] = a3 * c1[3] + b3 * c1[2]; }
                    wq[2 * bj] = __builtin_amdgcn_cvt_pk_fp8_f32(v0[0] * Q_SC, v0[1] * Q_SC, 0u, false); wq[2 * bj] = __builtin_amdgcn_cvt_pk_fp8_f32(v0[2] * Q_SC, v0[3] * Q_SC, wq[2 * bj], true);
                    wq[2 * bj + 1] = __builtin_amdgcn_cvt_pk_fp8_f32(v1[0] * Q_SC, v1[1] * Q_SC, 0u, false); wq[2 * bj + 1] = __builtin_amdgcn_cvt_pk_fp8_f32(v1[2] * Q_SC, v1[3] * Q_SC, wq[2 * bj + 1], true); }
                u32x4 w; w.x = wq[0]; w.y = wq[1]; w.z = wq[2]; w.w = wq[3];
                *(PG8_GAS u32x4*)rowp = w; }
    }
};
struct EpiMoe1 {
    static constexpr bool PERM = true, AFTER_DRAIN = false, PROBE_TWICE = false, LDS_PARAMS = true, PERM2 = true, FP8 = true, KT1 = true, SWAP12 = true;
    unsigned char* O; const float* b1;
    __device__ __forceinline__ void prefetch(const Unit& u, PG8_LAS unsigned char* slot, int lane) const { __builtin_amdgcn_global_load_lds((const unsigned*)(b1 + (size_t)u.e * 2048 + u.pn * BM + lane * 4), (PG8_LAS unsigned*)slot, 16, 0, 0); }
    __device__ __forceinline__ void operator()(const f32x4 (&acc)[2][2][4][2], const Unit& u, int wr, int wc, int fr, int fq, const PG8_LAS unsigned char* ps) const {
        const PG8_LAS float* bp = (const PG8_LAS float*)ps + wc * 64 + 16 * fq;
        f32x4 bv[2][2];
#pragma unroll
        for (int bj = 0; bj < 2; ++bj)
#pragma unroll
            for (int n = 0; n < 2; ++n) { const f32x4 b_ = *(const PG8_LAS f32x4*)(bp + bj * 8 + 4 * n); bv[bj][n] = __builtin_shufflevector(b_, b_, 0, 2, 1, 3); }
        typedef float f32x2 __attribute__((ext_vector_type(2)));
#pragma unroll
        for (int ai = 0; ai < 2; ++ai)
#pragma unroll
            for (int m = 0; m < 4; ++m) { unsigned char* rowp = O + ((size_t)((u.pm * 16 + wr * 4 + ai * 8 + m) * 32 + u.pn * 4 + wc) * 512 + fr * 32 + 8 * fq);
                u32x2 w;
#pragma unroll
                for (int bj = 0; bj < 2; ++bj) { unsigned wq = 0u;
#pragma unroll
                    for (int n = 0; n < 2; ++n) { const f32x4 v = acc[ai][bj][m][n] * (1.0f / W1_SC) + bv[bj][n];
                        const f32x2 g = {v[0], v[1]}, l = {v[2], v[3]};
                        const f32x2 xg = {fminf(g.x, 7.0f), fminf(g.y, 7.0f)}, xl = {fminf(fmaxf(l.x, -7.0f), 7.0f), fminf(fmaxf(l.y, -7.0f), 7.0f)};
                        const f32x2 tt = xg * -2.4554669595930156f;
                        const f32x2 d = (f32x2){__builtin_amdgcn_exp2f(tt.x), __builtin_amdgcn_exp2f(tt.y)} + 1.0f;
                        const f32x2 r = {__builtin_amdgcn_rcpf(d.x), __builtin_amdgcn_rcpf(d.y)};
                        const f32x2 o = (xg * (xl * H_SC + H_SC)) * r;
                        wq = (n == 0) ? __builtin_amdgcn_cvt_pk_fp8_f32(o.x, o.y, wq, false) : __builtin_amdgcn_cvt_pk_fp8_f32(o.x, o.y, wq, true); }
                    if (bj == 0) w.x = wq; else w.y = wq; }
                *(PG8_GAS u32x2*)rowp = w; }
    }
};
struct EpiMoe2 {
    static constexpr bool PERM = true, AFTER_DRAIN = false, PROBE_TWICE = false, LDS_PARAMS = true, PERM2 = true, FP8 = true, KT1 = true, SWAP12 = false;
    bf16_t* O; const float* b2;
    __device__ __forceinline__ void prefetch(const Unit& u, PG8_LAS unsigned char* slot, int lane) const { __builtin_amdgcn_global_load_lds((const unsigned*)(b2 + (size_t)u.e * 1024 + u.pn * BM + lane * 4), (PG8_LAS unsigned*)slot, 16, 0, 0); }
    __device__ __forceinline__ void operator()(const f32x4 (&acc)[2][2][4][2], const Unit& u, int wr, int wc, int fr, int fq, const PG8_LAS unsigned char* ps) const {
        const int row0 = u.pm * BM + wr * 64 + fr, cl = wc * 64 + 16 * fq, col0 = u.pn * BM + cl;
        const PG8_LAS float* bp = (const PG8_LAS float*)ps + cl;
        f32x4 bv[2][2];
#pragma unroll
        for (int bj = 0; bj < 2; ++bj)
#pragma unroll
            for (int n = 0; n < 2; ++n) bv[bj][n] = *(const PG8_LAS f32x4*)(bp + bj * 8 + 4 * n);
#pragma unroll
        for (int ai = 0; ai < 2; ++ai)
#pragma unroll
            for (int m = 0; m < 4; ++m) { unsigned char* rowp = (unsigned char*)O + (size_t)(row0 + ai * HALF + m * 16) * 1024 + col0;
                u32x4 w; unsigned wq[4];
#pragma unroll
                for (int bj = 0; bj < 2; ++bj) { const f32x4 v0 = acc[ai][bj][m][0] * (1.0f / (W2_SC * H_SC)) + bv[bj][0], v1 = acc[ai][bj][m][1] * (1.0f / (W2_SC * H_SC)) + bv[bj][1];
                    wq[2 * bj] = __builtin_amdgcn_cvt_pk_fp8_f32(v0[0], v0[1], 0u, false); wq[2 * bj] = __builtin_amdgcn_cvt_pk_fp8_f32(v0[2], v0[3], wq[2 * bj], true);
                    wq[2 * bj + 1] = __builtin_amdgcn_cvt_pk_fp8_f32(v1[0], v1[1], 0u, false); wq[2 * bj + 1] = __builtin_amdgcn_cvt_pk_fp8_f32(v1[2], v1[3], wq[2 * bj + 1], true); }
                w.x = wq[0]; w.y = wq[1]; w.z = wq[2]; w.w = wq[3];
                *(PG8_GAS u32x4*)rowp = w; }
    }
};
struct MoeOrder : StaticOrder {
    int pmmask = -1;
    const PG8_LAS unsigned char* tile_e; const PG8_LAS int* tstart; const PG8_LAS int* cnt; int cap;
    __device__ __forceinline__ bool next(int i, Unit& u) const {
        if (!StaticOrder::next(i, u)) return false;
        u.e = __builtin_amdgcn_readfirstlane((int)tile_e[u.pm]); u.pb = u.e * nN + u.pn; u.kr = KROT ? ((u.e + u.pn) & 3) : 0;
        const int ti = u.pm - __builtin_amdgcn_readfirstlane(tstart[u.e]); u.g0 = u.e * cap + ti * BM; u.gc = __builtin_amdgcn_readfirstlane(cnt[u.e]) - ti * BM; u.pm &= pmmask; return true;
    }
};

template <class Epi, class Sched, bool ALIGN_EPI = false, bool SP2 = false, bool GATHER = false, bool ATILED = false>
__device__ __forceinline__ void gemm_phase(PG8_LAS unsigned char* lds, const Gemm g, const Sched& S, const Epi& E, const int wave_s, const int* gtab = nullptr, PG8_LAS unsigned char* par = nullptr) {
    static_assert((!GATHER && !ATILED && !Epi::PERM2) || SP2, "gather / tiled A are wired into the SP2 loop only"); static_assert(!(GATHER && ATILED), "one or the other");
    int tid_ = tid_of(wave_s); asm volatile("" : "+v"(tid_));
    const int tid = tid_, wid = __builtin_amdgcn_readfirstlane(tid >> 6), lane = tid & 63, wr = wid >> 2, wc = wid & 3, fr = lane & 15, fq = lane >> 4;
    const int K = g.K, nt = K / BK;
    unsigned voffA[2], voffB[2];
#pragma unroll
    for (int i = 0; i < 2; ++i) { int R, C; stage_rc(tid * 16 + i * 8192, R, C); const int Rb = Epi::PERM2 ? (64 * (R >> 5) + 16 * ((R & 15) >> 2) + 4 * ((R >> 4) & 1) + (Epi::SWAP12 ? (((R & 1) << 1) | ((R >> 1) & 1)) : (R & 3)))        : Epi::PERM ? ((R & ~31) + perm32(R & 31)) : R;
        voffA[i] = ATILED ? (unsigned)(((R >> 4) * (K >> 4) + (C >> 4)) * 256 + (R & 15) * 16 + (C & 15)) * 2u : (unsigned)(R * K + C) * 2u; voffB[i] = (unsigned)(((Rb >> 4) * (K >> 5) + (C >> 5)) * 512 + (Rb & 15) * 32 + (C & 31)) * 2u; }
    unsigned offC[2][2];
#define PG8_GOFF(dst, u) do { _Pragma("unroll") for (int h_ = 0; h_ < 2; ++h_) _Pragma("unroll") for (int i_ = 0; i_ < 2; ++i_) { int R_, C_; stage_rc(tid * 16 + i_ * 8192, R_, C_); const int rr_ = h_ * HALF + R_; \
        const int a_ = (rr_ < (u).gc) ? *(const PG8_GAS int*)(gtab + (u).g0 + rr_) : 0; dst[h_][i_] = (unsigned)((a_ >> 2) * K + C_) * 2u; } } while (0)

    const size_t kstep = (size_t)(BK * 2);
    const size_t kstepA = ATILED ? (size_t)(BK / 16) * 512 : kstep;
    const size_t kstepB = (size_t)(BK / 32) * 1024;
    const size_t hstep = (size_t)HALF * K * 2;
    const size_t tstep = 2 * hstep;
    const size_t hstepB = Epi::PERM2 ? (size_t)(8 * 32 * 2) : hstep;
    const unsigned ldsw = (unsigned)wid * 1024u;
    const int aoff = lds_byte(wr * 64 + fr, fq * 8), boff = lds_byte(wc * 32 + fr, fq * 8);
#define PG8_SA(b, h) (((b) * 2 + (h)) * HTB)
#define PG8_SB(b, h) ((4 + (b) * 2 + (h)) * HTB)
#define PG8_STAGE(bufoff, gbase, voff) do { _Pragma("unroll") for (int _i = 0; _i < 2; ++_i) \
        __builtin_amdgcn_global_load_lds((const unsigned*)((const char*)(gbase) + (voff)[_i]), (PG8_LAS unsigned*)(lds + (bufoff) + ldsw + _i * 8192), 16, 0, 0); } while (0)
#define PG8_STAGE_A(bufoff, kptr, h) do { if constexpr (GATHER) { PG8_STAGE(bufoff, kptr, offC[h]); } else { PG8_STAGE(bufoff, (kptr) + ((h) ? hstep : 0), voffA); } } while (0)
#define PG8_CAT(x0, x1) __builtin_shufflevector(x0, x1, 0, 1, 2, 3, 4, 5, 6, 7)
#define PG8_LDA(dst, b, h) do { _Pragma("unroll") for (int m = 0; m < 4; ++m) { if constexpr (Epi::FP8) dst##8[m] = PG8_CAT(*(const PG8_LAS i32x4*)(lds + PG8_SA(b, h) + aoff + m * 2048), *(const PG8_LAS i32x4*)(lds + PG8_SA(b, h) + aoff + m * 2048 + 1024)); \
        else { _Pragma("unroll") for (int k = 0; k < 2; ++k) dst[m][k] = *(const PG8_LAS bf16x8*)(lds + PG8_SA(b, h) + aoff + m * 2048 + k * 1024); } } } while (0)
#define PG8_LDB(dst, b, h) do { _Pragma("unroll") for (int n = 0; n < 2; ++n) { if constexpr (Epi::FP8) dst##8[n] = PG8_CAT(*(const PG8_LAS i32x4*)(lds + PG8_SB(b, h) + boff + n * 2048), *(const PG8_LAS i32x4*)(lds + PG8_SB(b, h) + boff + n * 2048 + 1024)); \
        else { _Pragma("unroll") for (int k = 0; k < 2; ++k) dst[n][k] = *(const PG8_LAS bf16x8*)(lds + PG8_SB(b, h) + boff + n * 2048 + k * 1024); } } } while (0)
#define PG8_MMA(ai, bj, At, Bt) do { __builtin_amdgcn_s_setprio(1); if constexpr (Epi::FP8) { _Pragma("unroll") for (int m = 0; m < 4; ++m) _Pragma("unroll") for (int n = 0; n < 2; ++n) \
        acc[ai][bj][m][n] = __builtin_amdgcn_mfma_scale_f32_16x16x128_f8f6f4(Bt##8[n], At##8[m], acc[ai][bj][m][n], 0, 0, 0, 0, 0, 0); } else { \
        _Pragma("unroll") for (int m = 0; m < 4; ++m) _Pragma("unroll") for (int n = 0; n < 2; ++n) _Pragma("unroll") for (int k = 0; k < 2; ++k) \
        acc[ai][bj][m][n] = __builtin_amdgcn_mfma_f32_16x16x32_bf16(Bt[n][k], At[m][k], acc[ai][bj][m][n], 0, 0, 0); } __builtin_amdgcn_s_setprio(0); } while (0)
#define PG8_MMAZ(ai, bj, At, Bt) do { __builtin_amdgcn_s_setprio(1); if constexpr (Epi::FP8) { _Pragma("unroll") for (int m = 0; m < 4; ++m) _Pragma("unroll") for (int n = 0; n < 2; ++n) \
        acc[ai][bj][m][n] = __builtin_amdgcn_mfma_scale_f32_16x16x128_f8f6f4(Bt##8[n], At##8[m], (f32x4){0.f, 0.f, 0.f, 0.f}, 0, 0, 0, 0, 0, 0); } else { \
        _Pragma("unroll") for (int m = 0; m < 4; ++m) _Pragma("unroll") for (int n = 0; n < 2; ++n) { acc[ai][bj][m][n] = __builtin_amdgcn_mfma_f32_16x16x32_bf16(Bt[n][0], At[m][0], (f32x4){0.f, 0.f, 0.f, 0.f}, 0, 0, 0); \
            acc[ai][bj][m][n] = __builtin_amdgcn_mfma_f32_16x16x32_bf16(Bt[n][1], At[m][1], acc[ai][bj][m][n], 0, 0, 0); } } __builtin_amdgcn_s_setprio(0); } while (0)
#define PG8_WAIT_V(n) asm volatile("s_waitcnt vmcnt(" #n ")" ::: "memory")
#define PG8_WAIT_L(n) asm volatile("s_waitcnt lgkmcnt(" #n ")" ::: "memory")
#define PG8_BAR __builtin_amdgcn_s_barrier()
#define PG8_SCHED __builtin_amdgcn_sched_barrier(0)
    Unit cur, nxt; int ui = 0;
    if (!S.next(0, cur)) return;
    f32x4 acc[2][2][4][2];
    if constexpr (!Epi::KT1) {
#pragma unroll
    for (int a = 0; a < 2; ++a)
#pragma unroll
        for (int b = 0; b < 2; ++b)
#pragma unroll
            for (int m = 0; m < 4; ++m)
#pragma unroll
                for (int n = 0; n < 2; ++n) acc[a][b][m][n] = (f32x4){0.f, 0.f, 0.f, 0.f};
    }
    bf16x8 At[4][2], B0[2][2], B1[2][2]; i32x8 At8[4], B08[2], B18[2]; (void)At; (void)B0; (void)B1; (void)At8; (void)B08; (void)B18;
    const char* cA = (const char*)g.A + (GATHER ? (size_t)0 : (size_t)cur.pm * tstep); const char* cB = (const char*)g.Bt + (size_t)cur.pb * tstep;
    if constexpr (GATHER) PG8_GOFF(offC, cur);
    const int ntm = nt - 1, ntq = nt >> 2; int ck = (cur.kr * ntq) & ~1;
    cA += (size_t)ck * kstepA; cB += (size_t)ck * kstepB;
    S.a_ready(cur);
    if constexpr (SP2) {
        PG8_STAGE(PG8_SB(0, 0), cB, voffB); PG8_STAGE(PG8_SB(0, 1), cB + hstepB, voffB); PG8_STAGE_A(PG8_SA(0, 0), cA, 0); PG8_STAGE_A(PG8_SA(0, 1), cA, 1);
        if (wr == 1) PG8_BAR;
        PG8_WAIT_V(2); PG8_BAR;
        PG8_STAGE(PG8_SB(1, 0), cB + kstepB, voffB); PG8_STAGE_A(PG8_SA(1, 0), cA + kstepA, 0); PG8_STAGE(PG8_SB(1, 1), cB + hstepB + kstepB, voffB);
        PG8_WAIT_V(6); PG8_BAR;
    } else {
        PG8_STAGE(PG8_SB(0, 0), cB, voffB); PG8_STAGE(PG8_SA(0, 0), cA, voffA); PG8_STAGE(PG8_SB(0, 1), cB + hstep, voffB); PG8_STAGE(PG8_SA(0, 1), cA + hstep, voffA);
        if (wr == 1) PG8_BAR;
        PG8_WAIT_V(4); PG8_BAR;
        PG8_STAGE(PG8_SB(1, 0), cB + kstepB, voffB); PG8_STAGE(PG8_SA(1, 0), cA + kstep, voffA); PG8_STAGE(PG8_SB(1, 1), cB + hstep + kstepB, voffB);
        PG8_WAIT_V(6); PG8_BAR;
    }
    for (;;) {
        const bool has_next = S.next(ui + 1, nxt);
        if constexpr (GATHER) { if (has_next && wid < 4) __builtin_amdgcn_global_load_lds((const unsigned*)(gtab + nxt.g0 + 64 * wid + lane), (PG8_LAS unsigned*)(par + 2048 + wid * 256), 4, 0, 0); }
        if constexpr (Epi::LDS_PARAMS) { if (wid == 0) E.prefetch(cur, par + (ui & 1) * 1024, lane); }
        const int nk = has_next ? ((nxt.kr * ntq) & ~1) : ck;
        const char* nA = has_next ? (const char*)g.A + (GATHER ? (size_t)0 : (size_t)nxt.pm * tstep) + (size_t)nk * kstepA : cA; const char* nB = has_next ? (const char*)g.Bt + (size_t)nxt.pb * tstep + (size_t)nk * kstepB : cB;
        if constexpr (Epi::KT1) {
        static_assert(SP2 && !KROT, "the one-K-tile loop is the SP2 schedule without K rotation");
#define PG8_KT1_TRIP(MMA_) do { \
            const int b = t & 1, t1 = t + 1, t2 = t + 2; \
            asm volatile("" : "+v"(voffA[0]), "+v"(voffA[1]), "+v"(voffB[0]), "+v"(voffB[1])); \
            const char* a1 = (t1 < nt) ? cA + (size_t)t1 * kstepA : nA; \
            const char* a2 = (t2 < nt) ? cA + (size_t)t2 * kstepA : nA + (size_t)(t2 - nt) * kstepA; const char* b2 = (t2 < nt) ? cB + (size_t)t2 * kstepB : nB + (size_t)(t2 - nt) * kstepB; \
            if (t == nt - 2 && has_next) S.a_ready(nxt); \
              \
            PG8_LDB(B0, b, 0); PG8_LDB(B1, b, 1); PG8_SCHED; PG8_LDA(At, b, 0); PG8_STAGE_A(PG8_SA(b ^ 1, 1), a1, 1); \
            if constexpr (GATHER) { if (t == nt - 2 && has_next) { \
                _Pragma("unroll") for (int h_ = 0; h_ < 2; ++h_) _Pragma("unroll") for (int i_ = 0; i_ < 2; ++i_) { int R_, C_; stage_rc(tid * 16 + i_ * 8192, R_, C_); const int rr_ = h_ * HALF + R_; \
                    const int a_ = (rr_ < nxt.gc) ? *(const PG8_LAS int*)(par + 2048 + rr_ * 4) : 0; offC[h_][i_] = (unsigned)((a_ >> 2) * K + C_) * 2u; } } } \
            PG8_WAIT_V(8); PG8_WAIT_L(0); PG8_BAR; MMA_(0, 0, At, B0); MMA_(0, 1, At, B1); PG8_BAR; PG8_SCHED; \
              \
            PG8_LDA(At, b, 1); PG8_STAGE(PG8_SB(b, 0), b2, voffB); PG8_STAGE(PG8_SB(b, 1), b2 + hstepB, voffB); PG8_STAGE_A(PG8_SA(b, 0), a2, 0); \
            PG8_WAIT_V(8); PG8_WAIT_L(0); PG8_BAR; MMA_(1, 0, At, B0); MMA_(1, 1, At, B1); PG8_BAR; PG8_SCHED; } while (0)
        { const int t = 0; PG8_KT1_TRIP(PG8_MMAZ); }
#pragma unroll 1
        for (int t = 1; t < nt; ++t) PG8_KT1_TRIP(PG8_MMA);
#undef PG8_KT1_TRIP
        } else
#pragma unroll 1
        for (int t = 0; t < nt; t += 2) {
            const bool last = (t == nt - 2);
            if constexpr (Epi::FP8) asm volatile("" : "+v"(voffA[0]), "+v"(voffA[1]), "+v"(voffB[0]), "+v"(voffB[1]));
            const long s1_ = ((ck + t + 1) & ntm) - ck, s2_ = ((ck + t + 2) & ntm) - ck; const long d1 = s1_ * (long)kstepA, d2 = s2_ * (long)kstepA, d2b = s2_ * (long)kstepB;
            const char* a1 = cA + d1;
            const char* a2 = last ? nA : cA + d2; const char* b2 = last ? nB : cB + d2b;
            const char* a3 = a2 + kstepA; const char* b3 = b2 + kstepB;
            if (last && has_next) S.a_ready(nxt);
            if constexpr (SP2) {
            PG8_LDB(B0, 0, 0); PG8_LDB(B1, 0, 1); PG8_SCHED; PG8_LDA(At, 0, 0); PG8_STAGE_A(PG8_SA(1, 1), a1, 1);
            if constexpr (GATHER) { if (last && has_next) {
                _Pragma("unroll") for (int h_ = 0; h_ < 2; ++h_) _Pragma("unroll") for (int i_ = 0; i_ < 2; ++i_) { int R_, C_; stage_rc(tid * 16 + i_ * 8192, R_, C_); const int rr_ = h_ * HALF + R_;
                    const int a_ = (rr_ < nxt.gc) ? *(const PG8_LAS int*)(par + 2048 + rr_ * 4) : 0; offC[h_][i_] = (unsigned)((a_ >> 2) * K + C_) * 2u; } } }
            PG8_WAIT_V(8); PG8_WAIT_L(0); PG8_BAR; PG8_MMA(0, 0, At, B0); PG8_MMA(0, 1, At, B1); PG8_BAR; PG8_SCHED;
            PG8_LDA(At, 0, 1); PG8_STAGE(PG8_SB(0, 0), b2, voffB); PG8_STAGE(PG8_SB(0, 1), b2 + hstepB, voffB); PG8_STAGE_A(PG8_SA(0, 0), a2, 0);
            PG8_WAIT_V(8); PG8_WAIT_L(0); PG8_BAR; PG8_MMA(1, 0, At, B0); PG8_MMA(1, 1, At, B1); PG8_BAR; PG8_SCHED;
            PG8_LDB(B0, 1, 0); PG8_LDB(B1, 1, 1); PG8_SCHED; PG8_LDA(At, 1, 0); PG8_STAGE_A(PG8_SA(0, 1), a2, 1);
            PG8_WAIT_V(8); PG8_WAIT_L(0); PG8_BAR; PG8_MMA(0, 0, At, B0); PG8_MMA(0, 1, At, B1); PG8_BAR; PG8_SCHED;
            PG8_LDA(At, 1, 1); PG8_STAGE(PG8_SB(1, 0), b3, voffB); PG8_STAGE(PG8_SB(1, 1), b3 + hstepB, voffB); PG8_STAGE_A(PG8_SA(1, 0), a3, 0);
            PG8_WAIT_V(8); PG8_WAIT_L(0); PG8_BAR; PG8_MMA(1, 0, At, B0); PG8_MMA(1, 1, At, B1); PG8_BAR; PG8_SCHED;
            } else {
            PG8_LDB(B0, 0, 0); PG8_SCHED; PG8_LDA(At, 0, 0); PG8_STAGE(PG8_SA(1, 1), a1 + hstep, voffA);
            PG8_WAIT_L(8); PG8_BAR; PG8_WAIT_L(0); PG8_MMA(0, 0, At, B0); PG8_BAR; PG8_SCHED;
            PG8_LDB(B1, 0, 1); PG8_STAGE(PG8_SB(0, 0), b2, voffB);
            PG8_BAR; PG8_WAIT_L(0); PG8_MMA(0, 1, At, B1); PG8_BAR;
            PG8_LDA(At, 0, 1); PG8_STAGE(PG8_SA(0, 0), a2, voffA);
            PG8_BAR; PG8_WAIT_L(0); PG8_MMA(1, 0, At, B0); PG8_BAR; PG8_SCHED;
            PG8_STAGE(PG8_SB(0, 1), b2 + hstep, voffB);
            PG8_WAIT_V(6); PG8_BAR; PG8_MMA(1, 1, At, B1); PG8_BAR;
            PG8_LDB(B0, 1, 0); PG8_SCHED; PG8_LDA(At, 1, 0); PG8_STAGE(PG8_SA(0, 1), a2 + hstep, voffA);
            PG8_WAIT_L(8); PG8_BAR; PG8_WAIT_L(0); PG8_MMA(0, 0, At, B0); PG8_BAR; PG8_SCHED;
            PG8_LDB(B1, 1, 1); PG8_STAGE(PG8_SB(1, 0), b3, voffB);
            PG8_BAR; PG8_WAIT_L(0); PG8_MMA(0, 1, At, B1); PG8_BAR;
            PG8_LDA(At, 1, 1); PG8_STAGE(PG8_SA(1, 0), a3, voffA);
            PG8_BAR; PG8_WAIT_L(0); PG8_MMA(1, 0, At, B0); PG8_BAR; PG8_SCHED;
            PG8_STAGE(PG8_SB(1, 1), b3 + hstep, voffB);
            PG8_WAIT_V(6); PG8_BAR; PG8_MMA(1, 1, At, B1); PG8_BAR;
            }
        }
        if constexpr (ALIGN_EPI) { if (wr == 0) PG8_BAR; }
        if constexpr (!Epi::AFTER_DRAIN) { int fr2, fq2; if constexpr (Epi::FP8) { const int l2_ = tid_of(0); fr2 = l2_ & 15; fq2 = l2_ >> 4; } else { fr2 = fr; fq2 = fq; asm volatile("" : "+v"(fr2), "+v"(fq2)); }
            if constexpr (Epi::LDS_PARAMS) E(acc, cur, wr, wc, fr2, fq2, par + (ui & 1) * 1024); else E(acc, cur, wr, wc, fr2, fq2);
            S.done(cur); }
        if (!has_next) break;
        if constexpr (!Epi::KT1)
#pragma unroll
        for (int a = 0; a < 2; ++a)
#pragma unroll
            for (int b = 0; b < 2; ++b)
#pragma unroll
                for (int m = 0; m < 4; ++m)
#pragma unroll
                    for (int n = 0; n < 2; ++n) acc[a][b][m][n] = (f32x4){0.f, 0.f, 0.f, 0.f};
        cur = nxt; cA = nA; cB = nB; ck = nk; ++ui;
        if constexpr (ALIGN_EPI) { if (wr == 1) PG8_BAR; }
    }
    PG8_WAIT_V(0);
    if constexpr (!ALIGN_EPI) { if (wr == 0) PG8_BAR; }
    PG8_BAR;
    if constexpr (Epi::AFTER_DRAIN) { E.fused(acc, cur, wr, wc, fr, fq, lds, wid, lane); S.done(cur); }
#undef PG8_SA
#undef PG8_SB
#undef PG8_STAGE
#undef PG8_STAGE_A
#undef PG8_GOFF
#undef PG8_LDA
#undef PG8_LDB
#undef PG8_MMA
#undef PG8_MMAZ
#undef PG8_CAT
#undef PG8_WAIT_V
#undef PG8_WAIT_L
#undef PG8_BAR
#undef PG8_SCHED
}
}

#define GAS __attribute__((address_space(1)))
#define LAS __attribute__((address_space(3)))
typedef unsigned short bf16;
typedef unsigned v4u __attribute__((ext_vector_type(4)));
typedef float f32x4 __attribute__((ext_vector_type(4)));
typedef short bf16x8 __attribute__((ext_vector_type(8)));
typedef GAS unsigned gu32;
typedef GAS unsigned long long gu64;
#define RLX_AGENT __ATOMIC_RELAXED, __HIP_MEMORY_SCOPE_AGENT
#define LDS_WAIT() asm volatile("s_waitcnt lgkmcnt(0)" ::: "memory")
#define VM_WAIT() asm volatile("s_waitcnt vmcnt(0)" ::: "memory")
__device__ __forceinline__ unsigned long long rt() { return __builtin_amdgcn_s_memrealtime(); }
__device__ __forceinline__ unsigned f2bf(float f) { unsigned u = __builtin_bit_cast(unsigned, f); return (u + 0x7fffu + ((u >> 16) & 1u)) >> 16; }
__device__ __forceinline__ unsigned pk2(float lo, float hi) { return f2bf(lo) | (f2bf(hi) << 16); }

#define XB_TMO      128
#define XB_XCNT(j)  (256  + 64 * (j))
#define XB_XSUB(j)  (1280 + 64 * (j))
#define XB_XGEN(j)  (2304 + 64 * (j))
#define XB_TOP      3328
#define XB_TOPGEN   3392
#define XCD_BAR_WORDS 3456
#define XB_SPIN_CAP (1u << 20)

__device__ __forceinline__ unsigned xb_ld(unsigned* p)              { return __hip_atomic_load((GAS unsigned*)p, __ATOMIC_RELAXED, __HIP_MEMORY_SCOPE_AGENT); }
__device__ __forceinline__ unsigned xb_add(unsigned* p, unsigned v) { return __hip_atomic_fetch_add((GAS unsigned*)p, v, __ATOMIC_RELAXED, __HIP_MEMORY_SCOPE_AGENT); }
__device__ __forceinline__ unsigned xb_xcc_id() { return (unsigned)__builtin_amdgcn_s_getreg((3 << 11) | 20) & 0xFu; }
#define XB_SPIN(cond, bar) do { unsigned _sp = 0; while (cond) { __builtin_amdgcn_s_sleep(1); \
    if ((++_sp & 255u) == 0u) { if (xb_ld(&(bar)[XB_TMO])) break; if (_sp > XB_SPIN_CAP) { (void)xb_add(&(bar)[XB_TMO], 1u); break; } } } } while (0)

struct XcdBarrier {
    int wave_s;
    unsigned* bar; unsigned x;
    volatile LAS unsigned* st;
};

__device__ __forceinline__ XcdBarrier xcd_barrier_post(unsigned* bar, volatile LAS unsigned* st, int wave_s) {
    XcdBarrier b; b.wave_s = wave_s; b.bar = bar; b.x = xb_xcc_id(); b.st = st;
    if (tid_of(wave_s) == 0) (void)xb_add(&bar[XB_XCNT(b.x)], 1u);
    return b;
}
__device__ __forceinline__ void xcd_barrier_complete(unsigned* bar, unsigned x, unsigned& nloc, unsigned& nx) {
    const unsigned G = gridDim.x * gridDim.y * gridDim.z;
    unsigned sum, cnt, mine, sp = 0u;
    for (;;) {
        sum = 0u; cnt = 0u; mine = 0u;
#pragma unroll
        for (unsigned j = 0; j < 16; ++j) { const unsigned c = xb_ld(&bar[XB_XCNT(j)]); sum += c; cnt += (c > 0u) ? 1u : 0u; mine = (j == x) ? c : mine; }
        if (sum == G) break;
        __builtin_amdgcn_s_sleep(1);
        if ((++sp & 255u) == 0u) { if (xb_ld(&bar[XB_TMO])) break; if (sp > XB_SPIN_CAP) { (void)xb_add(&bar[XB_TMO], 1u); break; } }
    }
    nloc = mine > 0u ? mine : 1u; nx = cnt > 0u ? cnt : 1u;
}

__device__ __forceinline__ void xcd_barrier(const XcdBarrier& b) {
    asm volatile("s_waitcnt vmcnt(0)" ::: "memory");
    __syncthreads();
    if (tid_of(b.wave_s) == 0) {
        unsigned* bar = b.bar; asm volatile("" : "+s"(bar));
        __builtin_amdgcn_s_waitcnt(0);
        unsigned nloc = b.st[0], nx = b.st[1];
        if (nloc == 0u) { xcd_barrier_complete(bar, b.x, nloc, nx); b.st[0] = nloc; b.st[1] = nx; }
        const unsigned old = xb_add(&bar[XB_XSUB(b.x)], 1u);
        const unsigned gen = old / nloc;
        if (old + 1u == (gen + 1u) * nloc) {
            __builtin_amdgcn_fence(__ATOMIC_RELEASE, "agent");
            asm volatile("s_waitcnt vmcnt(0)" ::: "memory");
            const unsigned og = xb_add(&bar[XB_TOP], 1u);
            const unsigned tg = og / nx;
            if (og + 1u == (tg + 1u) * nx) xb_add(&bar[XB_TOPGEN], 1u);
            else XB_SPIN(xb_ld(&bar[XB_TOPGEN]) == tg, bar);
            __builtin_amdgcn_fence(__ATOMIC_ACQUIRE, "agent");
            xb_add(&bar[XB_XGEN(b.x)], 1u);
            asm volatile("s_waitcnt vmcnt(0)" ::: "memory");
        } else {
            XB_SPIN(xb_ld(&bar[XB_XGEN(b.x)]) == gen, bar);
            __builtin_amdgcn_fence(__ATOMIC_ACQUIRE, "agent");
            asm volatile("s_waitcnt vmcnt(0)" ::: "memory");
        }
    }
    __syncthreads();
}


constexpr int NWAVES = 8, NTHR = 512;
constexpr int BATCH = 32, SEQ = 2048, T = BATCH * SEQ, D = 1024, DEPTH = 4, N_A = 2;
constexpr int HGH = 8, HGD = 128;
constexpr int MH = 16, QR = 256, KVR = 128, QKD = 192, VD = 128;
constexpr int NE = 32, TOPK = 4, FF = 1024;
constexpr int NASSIGN = T * TOPK, MAXTILES = NASSIGN / 256 + NE, MAXROWS = MAXTILES * 256;
constexpr float DN_ALPHA = 1.6817928305074290f;
constexpr float LN_EPS = 1e-5f, RMS_EPS = 1e-6f;
constexpr float QSCALE = 0.07216878364870322f * 1.4426950408889634f;

constexpr size_t MiB = 1u << 20;
constexpr size_t WS_CTL = 0, CTL_ZERO_BYTES = 1 * MiB;
constexpr size_t WS_LBTAB = 1 * MiB;
constexpr size_t WS_ROPE = 2 * MiB;
constexpr size_t WS_HGWIN = 18 * MiB;
constexpr size_t WS_HGWO = 34 * MiB;
constexpr size_t WS_DQ = 38 * MiB;
constexpr size_t WS_UQ = 39 * MiB;
constexpr size_t WS_MWO = 42 * MiB;
constexpr size_t WS_KVA = 50 * MiB;
constexpr size_t WS_W1 = 64 * MiB;
constexpr size_t WS_X8 = 320 * MiB;
constexpr size_t WS_RIMG = 385 * MiB;
constexpr size_t RIMG_STRIDE = 2 * 32 * 1024 * 2 + 256;
constexpr size_t WS_STATS = 384 * MiB;
constexpr size_t WS_W2 = 576 * MiB;
constexpr size_t WS_XB = 832 * MiB;
constexpr size_t WS_TBUF = 960 * MiB;
constexpr size_t WS_BIG = 1216 * MiB;
constexpr size_t WS_ABUF = 1744 * MiB;
constexpr size_t WS_CKVT = 2272 * MiB;
constexpr size_t WS_CVT8 = 2320 * MiB;
constexpr size_t WS_CK8 = 2304 * MiB;
constexpr size_t WS_CKV = 2784 * MiB;
constexpr size_t WS_CQ = 2816 * MiB;
constexpr int ECAP = T;
constexpr size_t WS_RSLOT = 2848 * MiB;
constexpr size_t WS_ASG = 2856 * MiB;
constexpr size_t WS_AGATE = 2857 * MiB;
constexpr size_t WS_END = 2858 * MiB;
static_assert((size_t)MAXROWS * 1024 * 2 <= 528 * MiB && (size_t)NE * ECAP * 4 <= 8 * MiB, "ws map");
constexpr int CW_TMO = 0, CW_CODE = 1, CW_BAR = 4096, CW_CNT = 8192;
static_assert((CW_CNT + DEPTH * NE * 16) * 4 <= (int)CTL_ZERO_BYTES, "ctl");

constexpr int RING_OFF = 0, RING_BYTES = 131072;
constexpr int LDS_BYTES = 163840;
constexpr int LDSCTL_OFF = LDS_BYTES - 512, MISC_OFF = LDSCTL_OFF + 320;
constexpr int R1_WROW = 2064, R1_WHI = 0, R1_WLO = 32 * R1_WROW, R1_STAT = 2 * 32 * R1_WROW, R1_S12 = R1_STAT + 2048, R1_RED = R1_S12 + 256, R1_END = R1_RED + 4096;
constexpr int GP_OFF = RING_BYTES;
constexpr int TAB_OFF = R1_END;
constexpr int TAB_TSTART = TAB_OFF, TAB_TILEE = TAB_OFF + 256, TAB_LCNT = TAB_TILEE + 1280, TAB_LBASE = TAB_LCNT + 128, TAB_AE = TAB_LBASE + 128, TAB_ARANK = TAB_AE + 4096, TAB_AG = TAB_ARANK + 4096, TAB_END = TAB_AG + 4096;
static_assert(R1_END >= RING_BYTES + 3072 && TAB_END <= LDSCTL_OFF && R1_END % 16 == 0, "LDS map");
static_assert(MAXTILES <= 1280, "LDS map");

struct Args {
    const float* x; const int* pos; const float* ln_g; const float* ln_b; const float* hg_w_in; const float* hg_lb; const float* hg_gnorm; const float* hg_w_o;
    const float* mla_w_dq; const float* mla_q_norm; const float* mla_w_uq; const float* mla_w_o; const float* kv_w_a; const float* kv_norm; const float* kv_w_b;
    const float* router_w; const float* router_b; const float* moe_w1; const float* moe_b1; const float* moe_w2; const float* moe_b2;
    float* out; unsigned char* ws; int st_lo, st_hi, single, pad;
};

__device__ __forceinline__ float wave_sum(float v) {
#pragma unroll
    for (int o = 1; o < 64; o <<= 1) v += __shfl_xor(v, o);
    return v;
}
__device__ __forceinline__ float bf2f(unsigned short b) { return __builtin_bit_cast(float, (unsigned)b << 16); }
__device__ __forceinline__ float bflo(unsigned w) { return __builtin_bit_cast(float, w << 16); }
__device__ __forceinline__ float bfhi(unsigned w) { return __builtin_bit_cast(float, w & 0xffff0000u); }
typedef float f32x2_t __attribute__((ext_vector_type(2))); typedef __bf16 bf16x2_t __attribute__((ext_vector_type(2)));
__device__ __forceinline__ unsigned cvtpk(float lo, float hi) { const f32x2_t v = {lo, hi}; const bf16x2_t b = __builtin_convertvector(v, bf16x2_t); return __builtin_bit_cast(unsigned, b); }

__device__ __forceinline__ int map_row(int mode, int n) {
    if (mode == 1) { const int h = n / 192, r = n - h * 192; if (r < 128) return n; const int j = r - 128; return h * 192 + 128 + 2 * (j & 31) + (j >> 5); }
    if (mode == 2) { if (n < 128) return n; const int j = n - 128; return 128 + 2 * (j & 31) + (j >> 5); }
    return n;
}
__device__ __forceinline__ size_t wt_off(int n, int k, int ldk) { return ((size_t)(n >> 4) * (ldk >> 5) + (k >> 5)) * 512 + (n & 15) * 32 + (k & 31); }
__device__ __forceinline__ void transpose_item(const float* W, int K, int N, bf16* WT, int ldk, int mode, LAS float* scr, int item, int lane) {
    const int nblk = N / 64, kb = item / nblk, nb = item % nblk, k0 = 64 * kb, n0 = 64 * nb;
#pragma unroll 16
    for (int kk = 0; kk < 64; ++kk) scr[kk * 65 + lane] = W[(size_t)(k0 + kk) * N + n0 + lane];
    LDS_WAIT(); asm volatile("" ::: "memory");
    const int nl = lane >> 2, c4 = lane & 3;
#pragma unroll
    for (int blk = 0; blk < 8; ++blk) { const int n = 16 * (blk >> 1) + nl, kl = 32 * (blk & 1) + 8 * c4; const LAS float* s = scr + kl * 65 + n;
        v4u o; o.x = cvtpk(s[0 * 65], s[1 * 65]); o.y = cvtpk(s[2 * 65], s[3 * 65]); o.z = cvtpk(s[4 * 65], s[5 * 65]); o.w = cvtpk(s[6 * 65], s[7 * 65]);
        if (mode != 1 || ((n0 + n) % 192) >= 128) *(GAS v4u*)(WT + wt_off(map_row(mode, n0 + n), k0 + kl, ldk)) = o; }
    LDS_WAIT(); asm volatile("" ::: "memory");
}
__device__ __forceinline__ void transpose_item8(const float* W, int K, int N, unsigned char* WT, float sc, LAS float* scr, int item, int lane) {
    const int nblk = N / 64, kb = item / nblk, nb = item % nblk, k0 = 64 * kb, n0 = 64 * nb;
#pragma unroll 16
    for (int kk = 0; kk < 64; ++kk) scr[kk * 65 + lane] = W[(size_t)(k0 + kk) * N + n0 + lane];
    LDS_WAIT(); asm volatile("" ::: "memory");
    const int nl = lane >> 2, c4 = lane & 3;
#pragma unroll
    for (int blk = 0; blk < 4; ++blk) { const LAS float* s = scr + (16 * c4) * 65 + 16 * blk + nl; unsigned o[4];
#pragma unroll
        for (int j = 0; j < 4; ++j) { o[j] = __builtin_amdgcn_cvt_pk_fp8_f32(s[(4 * j) * 65] * sc, s[(4 * j + 1) * 65] * sc, 0u, false); o[j] = __builtin_amdgcn_cvt_pk_fp8_f32(s[(4 * j + 2) * 65] * sc, s[(4 * j + 3) * 65] * sc, o[j], true); }
        *(GAS v4u*)(WT + ((size_t)(4 * nb + blk) * (K >> 6) + kb) * 1024 + nl * 64 + 16 * c4) = (v4u){o[0], o[1], o[2], o[3]}; }
    LDS_WAIT(); asm volatile("" ::: "memory");
}
__device__ __forceinline__ void p0_prologue(const Args& A, LAS unsigned char* lds, int vcu, int G, int wave, int lane, int tid) {
    unsigned char* ws = A.ws;
    LAS float* scr = (LAS float*)(lds + RING_OFF + wave * 16640);
    const int gw = vcu * NWAVES + wave, NGW = G * NWAVES;
    constexpr int I_W1 = 128 * 16 * 32, I_W2 = 128 * 16 * 16, I_HIN = 2 * 16 * 64, I_HWO = 2 * 16 * 16, I_DQ = 2 * 16 * 4, I_UQ = 2 * 4 * 48, I_KVA = 16 * 3;
    constexpr int NITEMS = I_W1 + I_W2 + I_HIN + I_HWO + I_DQ + I_UQ + I_KVA;
    for (int it = gw; it < NITEMS; it += NGW) {
        int r = it;
        if (r < I_W1) { const int mat = r >> 9; transpose_item8(A.moe_w1 + (size_t)mat * 1024 * 2048, 1024, 2048, ws + WS_W1 + (size_t)mat * 2048 * 1024, pg8::W1_SC, scr, r & 511, lane); continue; } r -= I_W1;
        if (r < I_W2) { const int mat = r >> 8; transpose_item8(A.moe_w2 + (size_t)mat * 1024 * 1024, 1024, 1024, ws + WS_W2 + (size_t)mat * 1024 * 1024, pg8::W2_SC, scr, r & 255, lane); continue; } r -= I_W2;
        if (r < I_HIN) { const int mat = r / 1024; transpose_item8(A.hg_w_in + (size_t)mat * 1024 * 4096, 1024, 4096, ws + WS_HGWIN + (size_t)mat * 4096 * 1024, pg8::HIN_SC, scr, r % 1024, lane); continue; } r -= I_HIN;
        if (r < I_HWO) { const int mat = r / 256; transpose_item(A.hg_w_o + (size_t)mat * 1024 * 1024, 1024, 1024, (bf16*)(ws + WS_HGWO) + (size_t)mat * 1024 * 1024, 1024, 0, scr, r % 256, lane); continue; } r -= I_HWO;
        if (r < I_DQ) { const int mat = r / 64; transpose_item(A.mla_w_dq + (size_t)mat * 1024 * 256, 1024, 256, (bf16*)(ws + WS_DQ) + (size_t)mat * 256 * 1024, 1024, 0, scr, r % 64, lane); continue; } r -= I_DQ;
        if (r < I_UQ) { const int mat = r / 192; transpose_item(A.mla_w_uq + (size_t)mat * 256 * 3072, 256, 3072, (bf16*)(ws + WS_UQ) + (size_t)mat * 3072 * 256, 256, 1, scr, r % 192, lane); continue; } r -= I_UQ;
        transpose_item(A.kv_w_a, 1024, 192, (bf16*)(ws + WS_KVA), 1024, 2, scr, r, lane);
    }
    const int gt = vcu * NTHR + tid, NGT = G * NTHR;
    for (int i = gt; i < 8192; i += NGT) *(GAS v4u*)(ws + WS_KVA + (size_t)192 * 2048 + (size_t)i * 16) = (v4u){0u, 0u, 0u, 0u};
    for (int i = gt; i < 2048; i += NGT) { float v = 0.f; if (i >= 1024) { const float a = A.hg_lb[i - 1024], b = A.hg_lb[i]; v = 1.0f / (1.0f + expf(a - b)); } ((float*)(ws + WS_LBTAB))[i] = v; }
    for (int i = gt; i < T * 32; i += NGT) { const int tok = i >> 5, j = i & 31; const float inv = exp2f(-(float)j * (13.287712379549449f / 32.0f)); const float ang = (float)A.pos[tok] * inv; const double rev = (double)ang * 0.15915494309189535; const float fr = (float)(rev - rint(rev)); const float s = __builtin_amdgcn_sinf(fr), c = __builtin_amdgcn_cosf(fr);
        ((float2*)(ws + WS_ROPE))[i] = make_float2(c, s); }
    for (int it = vcu; it < 2 * 32 * 8; it += G) {
        const int kind = it >> 8, pj = (it >> 7) & 1, ph = (it >> 3) & 15, part = it & 7, r = tid & 127, q4 = tid >> 7;
        if (kind == 0) {
            const float* bw = A.kv_w_b + (size_t)r * 4096 + ph * 256; const float* aw = A.mla_w_uq + (size_t)pj * 256 * 3072 + (size_t)(32 * part + 8 * q4) * 3072 + ph * 192;
            float acc8[8] = {0.f, 0.f, 0.f, 0.f, 0.f, 0.f, 0.f, 0.f};
            for (int n = 0; n < 128; n += 4) { const f32x4 bv4 = *(const f32x4*)(bw + n);
#pragma unroll
                for (int i = 0; i < 8; ++i) { const f32x4 av4 = *(const f32x4*)(aw + (size_t)i * 3072 + n); acc8[i] += (av4.x * bv4.x + av4.y * bv4.y) + (av4.z * bv4.z + av4.w * bv4.w); } }
            *(GAS v4u*)((bf16*)(ws + WS_UQ) + (size_t)pj * 3072 * 256 + wt_off(ph * 192 + r, 32 * part + 8 * q4, 256)) = (v4u){cvtpk(acc8[0], acc8[1]), cvtpk(acc8[2], acc8[3]), cvtpk(acc8[4], acc8[5]), cvtpk(acc8[6], acc8[7])};
        } else {
            const float* bw = A.kv_w_b + (size_t)r * 4096 + ph * 256 + 128; const float* ow = A.mla_w_o + (size_t)pj * 2048 * 1024 + (size_t)(ph * 128) * 1024 + 128 * part + 32 * q4;
            float acc32[32];
#pragma unroll
            for (int i = 0; i < 32; ++i) acc32[i] = 0.f;
            for (int vd = 0; vd < 128; ++vd) { const float bvv = bw[vd];
#pragma unroll
                for (int i4 = 0; i4 < 8; ++i4) { const f32x4 w4 = *(const f32x4*)(ow + (size_t)vd * 1024 + 4 * i4); acc32[4 * i4] += bvv * w4.x; acc32[4 * i4 + 1] += bvv * w4.y; acc32[4 * i4 + 2] += bvv * w4.z; acc32[4 * i4 + 3] += bvv * w4.w; } }
            unsigned char* op_ = ws + WS_MWO + (size_t)pj * 1024 * 2048;
#pragma unroll
            for (int i = 0; i < 32; ++i) { const int n_ = 128 * part + 32 * q4 + i, k_ = ph * 128 + r; *(GAS unsigned char*)(op_ + ((size_t)(n_ >> 4) * 32 + (k_ >> 6)) * 1024 + (n_ & 15) * 64 + (k_ & 63)) = (unsigned char)(__builtin_amdgcn_cvt_pk_fp8_f32(acc32[i] * pg8::MWO_SC, 0.f, 0u, false) & 0xffu); }
        }
    }
    for (int it = gw; it < DEPTH * NE; it += NGW) { const int L = it / NE, e = it % NE; const float* rw = A.router_w + (size_t)L * D * NE; const float* lg = A.ln_g + (size_t)(L * 2 + 0) * D; const float* lb = A.ln_b + (size_t)(L * 2 + 0) * D;
        unsigned char* img = ws + WS_RIMG + (size_t)L * RIMG_STRIDE; float s1 = 0.f, s2 = 0.f;
#pragma unroll 4
        for (int k = 0; k < 16; ++k) { const int c = lane + 64 * k; const float w = rw[c * NE + e], wp = lg[c] * w; const unsigned hb = cvtpk(wp, 0.f) & 0xffffu; const float hf = __builtin_bit_cast(float, hb << 16);
            *(GAS unsigned short*)(img + (size_t)e * 2048 + c * 2) = (unsigned short)hb; *(GAS unsigned short*)(img + 65536 + (size_t)e * 2048 + c * 2) = (unsigned short)(cvtpk(wp - hf, 0.f) & 0xffffu);
            s1 += wp; s2 += lb[c] * w; }
        s1 = wave_sum(s1); s2 = wave_sum(s2);
        if (lane == 0) { *(GAS float*)(img + 131072 + e * 4) = s1; *(GAS float*)(img + 131072 + 128 + e * 4) = s2 + A.router_b[L * NE + e]; } }
    for (int m = gw; m < T; m += NGW) { const GAS f32x4* xr = (const GAS f32x4*)(A.x + (size_t)m * D) + lane; GAS unsigned long long* o8 = (GAS unsigned long long*)((bf16*)(ws + WS_XB) + (size_t)m * D) + lane;
#pragma unroll
        for (int j = 0; j < 4; ++j) { const f32x4 v = xr[64 * j]; o8[64 * j] = (unsigned long long)cvtpk(v.x, v.y) | ((unsigned long long)cvtpk(v.z, v.w) << 32);
            *(GAS unsigned*)(ws + WS_X8 + (size_t)m * D + 4 * lane + 256 * j) = __builtin_amdgcn_cvt_pk_fp8_f32(v.z, v.w, __builtin_amdgcn_cvt_pk_fp8_f32(v.x, v.y, 0u, false), true); } }
}

__device__ __forceinline__ void hg_scan_unit(const Args& A, int layer, int bh, LAS unsigned char* lds, int tid) {
    const int b = bh >> 3, h = bh & 7, v = tid & 127, kq = tid >> 7;
    const bf16* qfig = (const bf16*)(A.ws + WS_BIG); bf16* og = (bf16*)(A.ws + WS_ABUF);
    LAS float* Lq = (LAS float*)lds; LAS float* Lf = Lq + 4096; LAS float* Lk = Lf + 4096; LAS float* Li = Lk + 4096; LAS float* Po = Li + 4096;
    float S[32];
#pragma unroll
    for (int i = 0; i < 32; ++i) S[i] = 0.f;
    const int lt = tid >> 4, v0 = (tid & 15) * 8;
    f32x4 gn0 = *(const f32x4*)(A.hg_gnorm + layer * 128 + v0), gn1 = *(const f32x4*)(A.hg_gnorm + layer * 128 + v0 + 4);
    for (int t0 = 0; t0 < SEQ; t0 += 32) {
        const size_t rowoff = ((size_t)b * SEQ + t0 + lt) * 4096 + h * 128 + v0;
        const v4u wq = *(const GAS v4u*)(qfig + rowoff), wf = *(const GAS v4u*)(qfig + rowoff + 1024), wi = *(const GAS v4u*)(qfig + rowoff + 2048);
        const unsigned aq[4] = {wq.x, wq.y, wq.z, wq.w}, af[4] = {wf.x, wf.y, wf.z, wf.w}, ai[4] = {wi.x, wi.y, wi.z, wi.w};
#pragma unroll
        for (int j = 0; j < 4; ++j) { const int o = lt * 128 + v0 + 2 * j;
            Lq[o] = bflo(aq[j]); Lq[o + 1] = bfhi(aq[j]); Li[o] = bflo(ai[j]); Li[o + 1] = bfhi(ai[j]);
            const float f0 = __expf(bflo(af[j])), f1 = __expf(bfhi(af[j])); Lf[o] = f0; Lf[o + 1] = f1; Lk[o] = 1.0f - f0; Lk[o + 1] = 1.0f - f1; }
        __syncthreads();
        for (int t = 0; t < 32; ++t) {
            const float iv = Li[t * 128 + v]; float o = 0.f;
            const LAS f32x4* pf = (const LAS f32x4*)(Lf + t * 128 + kq * 32); const LAS f32x4* pk = (const LAS f32x4*)(Lk + t * 128 + kq * 32); const LAS f32x4* pq = (const LAS f32x4*)(Lq + t * 128 + kq * 32);
#pragma unroll
            for (int k4 = 0; k4 < 8; ++k4) { const f32x4 f4 = pf[k4], kk4 = pk[k4], q4 = pq[k4];
#pragma unroll
                for (int j = 0; j < 4; ++j) { S[4 * k4 + j] = f4[j] * S[4 * k4 + j] + kk4[j] * iv; o += S[4 * k4 + j] * q4[j]; } }
            Po[(kq * 32 + t) * 128 + v] = o;
        }
        __syncthreads();
        {
            float o8[8]; float ss = 0.f;
#pragma unroll
            for (int j = 0; j < 8; ++j) { o8[j] = (Po[(0 * 32 + lt) * 128 + v0 + j] + Po[(1 * 32 + lt) * 128 + v0 + j]) + (Po[(2 * 32 + lt) * 128 + v0 + j] + Po[(3 * 32 + lt) * 128 + v0 + j]); ss += o8[j] * o8[j]; }
            ss += __shfl_xor(ss, 1); ss += __shfl_xor(ss, 2); ss += __shfl_xor(ss, 4); ss += __shfl_xor(ss, 8);
            const float rstd = 1.0f / sqrtf(ss * (1.0f / 128.0f) + RMS_EPS);
            const v4u wg = *(const GAS v4u*)(qfig + rowoff + 3072); const unsigned ag[4] = {wg.x, wg.y, wg.z, wg.w};
            const float gn[8] = {gn0[0], gn0[1], gn0[2], gn0[3], gn1[0], gn1[1], gn1[2], gn1[3]};
            unsigned w[4];
#pragma unroll
            for (int j = 0; j < 4; ++j) w[j] = cvtpk(o8[2 * j] * rstd * gn[2 * j] * bflo(ag[j]), o8[2 * j + 1] * rstd * gn[2 * j + 1] * bfhi(ag[j]));
            *(GAS v4u*)(og + ((size_t)b * SEQ + t0 + lt) * 1024 + h * 128 + v0) = (v4u){w[0], w[1], w[2], w[3]};
        }
    }
    __syncthreads();
}

constexpr int HG_QROW = 288, HG_TROW = 80, HG_OROW = 132;
constexpr int HG_QD = 0, HG_KD = 32 * HG_QROW, HG_K2 = 2 * 32 * HG_QROW, HG_IV = HG_K2 + 128 * HG_TROW, HG_ER = HG_IV + 128 * HG_TROW, HG_EB = HG_ER + 512, HG_SET = HG_EB + 512;
constexpr int HG_OST = 2 * HG_SET, HG_OSTB = 32 * HG_OROW * 4, HG_RAW = HG_OST + 2 * HG_OSTB, HG_END = HG_RAW + 4 * 6144;
static_assert(HG_END <= R1_END && HG_SET % 16 == 0 && HG_OSTB % 16 == 0, "hgrn LDS");
typedef short s16x4 __attribute__((ext_vector_type(4)));
__device__ __forceinline__ void hg_chunk_unit(const Args& A, int layer, int bh, LAS unsigned char* lds, int tid) {
    const int b = bh >> 3, h = bh & 7;
    const int lane = tid & 63, w = __builtin_amdgcn_readfirstlane(tid >> 6);
    const bf16* qfig = (const bf16*)(A.ws + WS_BIG); bf16* og = (bf16*)(A.ws + WS_ABUF);
    constexpr int NCH = SEQ / 32;
    if (w < 4) {
        const int c = w * 32 + (lane & 31), half = lane >> 5;
        const int et = tid >> 3, ev0 = (tid & 7) * 16;
        const bf16* dsrc = qfig + ((size_t)(b * 128) * 128 + h * 4 + w) * 512 + lane * 8;
        LAS unsigned char* raw = lds + HG_RAW + w * 6144;
        const bf16* gp = qfig + ((size_t)(b * 128 + (et >> 4)) * 128 + 96 + h * 4 + (ev0 >> 5)) * 512 + (et & 15) * 32 + (ev0 & 31);
        bf16* op = og + ((size_t)b * SEQ + et) * 1024 + h * 128 + ev0;
        unsigned short rq[16], rf[16], ri[16];
#define HG_DMA(ch) do { const bf16* p_ = dsrc + (size_t)(ch) * 2 * 128 * 512; \
        _Pragma("unroll") for (int a = 0; a < 3; ++a) _Pragma("unroll") for (int j = 0; j < 2; ++j) \
            __builtin_amdgcn_global_load_lds((const unsigned*)(p_ + (size_t)j * 128 * 512 + a * 32 * 512), (LAS unsigned*)(raw + a * 2048 + j * 1024), 16, 0, 0); } while (0)
#define HG_LOAD(ch) do { const LAS unsigned char* r_ = raw + (16 * half) * 64 + (lane & 31) * 2; \
        _Pragma("unroll") for (int i = 0; i < 16; ++i) { rq[i] = *(const LAS unsigned short*)(r_ + i * 64); rf[i] = *(const LAS unsigned short*)(r_ + 2048 + i * 64); ri[i] = *(const LAS unsigned short*)(r_ + 4096 + i * 64); } } while (0)
#define HG_PRE(ch) do { int so_ = ((ch) & 1) * HG_SET; asm volatile("" : "+s"(so_)); LAS unsigned char* set = lds + so_; \
        float lf[16], bl[16]; float run = 0.f; \
        _Pragma("unroll") for (int i = 0; i < 16; ++i) { lf[i] = bf2f(rf[i]); run += lf[i]; bl[i] = run; } \
        const float oth = __shfl_xor(run, 32); const float off = half ? oth : 0.f, r = half ? oth : run, bL = run + oth, e3_ = __builtin_amdgcn_exp2f(bL - r); \
        unsigned k2[8]; \
        _Pragma("unroll") for (int i = 0; i < 16; i += 2) { float kd2v[2]; \
            _Pragma("unroll") for (int ii = 0; ii < 2; ++ii) { const float bb = off + bl[i + ii], kk = 1.0f - __builtin_amdgcn_exp2f(lf[i + ii]);        \
                const float qd = bf2f(rq[i + ii]) * __builtin_amdgcn_exp2f(bb - r), kd = kk * __builtin_amdgcn_exp2f(r - bb); kd2v[ii] = kd * e3_;        \
                *(LAS unsigned short*)(set + HG_QD + (16 * half + i + ii) * HG_QROW + c * 2) = (unsigned short)(cvtpk(qd, 0.f) & 0xffffu); \
                *(LAS unsigned short*)(set + HG_KD + (16 * half + i + ii) * HG_QROW + c * 2) = (unsigned short)(cvtpk(kd, 0.f) & 0xffffu); } \
            k2[i >> 1] = cvtpk(kd2v[0], kd2v[1]); } \
        *(LAS v4u*)(set + HG_K2 + c * HG_TROW + half * 32) = (v4u){k2[0], k2[1], k2[2], k2[3]}; *(LAS v4u*)(set + HG_K2 + c * HG_TROW + half * 32 + 16) = (v4u){k2[4], k2[5], k2[6], k2[7]}; \
        *(LAS v4u*)(set + HG_IV + c * HG_TROW + half * 32) = (v4u){(unsigned)ri[0] | ((unsigned)ri[1] << 16), (unsigned)ri[2] | ((unsigned)ri[3] << 16), (unsigned)ri[4] | ((unsigned)ri[5] << 16), (unsigned)ri[6] | ((unsigned)ri[7] << 16)}; \
        *(LAS v4u*)(set + HG_IV + c * HG_TROW + half * 32 + 16) = (v4u){(unsigned)ri[8] | ((unsigned)ri[9] << 16), (unsigned)ri[10] | ((unsigned)ri[11] << 16), (unsigned)ri[12] | ((unsigned)ri[13] << 16), (unsigned)ri[14] | ((unsigned)ri[15] << 16)}; \
        if (half == 0) { *(LAS float*)(set + HG_ER + c * 4) = __builtin_amdgcn_exp2f(r); *(LAS float*)(set + HG_EB + c * 4) = __builtin_amdgcn_exp2f(bL); } } while (0)
#define HG_EPI(ch, RG0, RG1) do { int oo_ = HG_OST + ((ch) & 1) * HG_OSTB; asm volatile("" : "+s"(oo_)); const LAS float* ost = (const LAS float*)(lds + oo_) + et * HG_OROW + ev0; \
        f32x4 ov[4], gn[4]; float ss = 0.f; \
        _Pragma("unroll") for (int i = 0; i < 4; ++i) gn[i] = *(const f32x4*)(A.hg_gnorm + layer * 128 + ev0 + 4 * i); \
        _Pragma("unroll") for (int i = 0; i < 4; ++i) { ov[i] = *(const LAS f32x4*)(ost + 4 * i); ss += (ov[i][0] * ov[i][0] + ov[i][1] * ov[i][1]) + (ov[i][2] * ov[i][2] + ov[i][3] * ov[i][3]); } \
        ss += __shfl_xor(ss, 1); ss += __shfl_xor(ss, 2); ss += __shfl_xor(ss, 4); \
        const float rstd = 1.0f / sqrtf(ss * (1.0f / 128.0f) + RMS_EPS); \
        const unsigned gw[8] = {RG0.x, RG0.y, RG0.z, RG0.w, RG1.x, RG1.y, RG1.z, RG1.w}; unsigned ow[8]; \
        _Pragma("unroll") for (int i = 0; i < 4; ++i) { const f32x4 y = ov[i] * rstd * gn[i]; ow[2 * i] = cvtpk(y[0] * bflo(gw[2 * i]), y[1] * bfhi(gw[2 * i])); ow[2 * i + 1] = cvtpk(y[2] * bflo(gw[2 * i + 1]), y[3] * bfhi(gw[2 * i + 1])); } \
        *(GAS v4u*)(op + (size_t)(ch) * 32 * 1024) = (v4u){ow[0], ow[1], ow[2], ow[3]}; *(GAS v4u*)(op + (size_t)(ch) * 32 * 1024 + 8) = (v4u){ow[4], ow[5], ow[6], ow[7]}; } while (0)
        HG_DMA(0); asm volatile("s_waitcnt vmcnt(0)" ::: "memory");
        HG_LOAD(0); HG_PRE(0);
        asm volatile("s_waitcnt lgkmcnt(0)" ::: "memory"); HG_DMA(1);
        __syncthreads();
        for (int ch = 0; ch < NCH; ++ch) {
            v4u rg0 = {0u, 0u, 0u, 0u}, rg1 = rg0;
            if (ch >= 1) { rg0 = *(const GAS v4u*)(gp + (size_t)(ch - 1) * 2 * 128 * 512); rg1 = *(const GAS v4u*)(gp + (size_t)(ch - 1) * 2 * 128 * 512 + 8); }
            if (ch + 1 < NCH) { HG_LOAD(ch + 1); HG_PRE(ch + 1); if (ch + 2 < NCH) { asm volatile("s_waitcnt lgkmcnt(0)" ::: "memory"); HG_DMA(ch + 2); } }
            if (ch >= 1) HG_EPI(ch - 1, rg0, rg1);
            __syncthreads();
        }
        { const v4u rg0 = *(const GAS v4u*)(gp + (size_t)(NCH - 1) * 2 * 128 * 512), rg1 = *(const GAS v4u*)(gp + (size_t)(NCH - 1) * 2 * 128 * 512 + 8); HG_EPI(NCH - 1, rg0, rg1); }
#undef HG_DMA
#undef HG_LOAD
#undef HG_PRE
#undef HG_EPI
    } else {
        const int m = w - 4, l15 = lane & 15, quad = lane >> 4;
        f32x4 S[2][8];
#pragma unroll
        for (int j = 0; j < 2; ++j)
#pragma unroll
            for (int mt = 0; mt < 8; ++mt) S[j][mt] = (f32x4){0.f, 0.f, 0.f, 0.f};
        __syncthreads();
        for (int ch = 0; ch < NCH; ++ch) {
            int so_ = (ch & 1) * HG_SET; asm volatile("" : "+s"(so_));
            const LAS unsigned char* set = lds + so_;
            f32x4 c00 = {0.f, 0.f, 0.f, 0.f}, c01 = c00, c11 = c00;
            {   const LAS unsigned char* ka = set + HG_KD + l15 * HG_QROW + quad * 16; const LAS unsigned char* qa = set + HG_QD + l15 * HG_QROW + quad * 16;
                bf16x8 fa0[4], fa1[4], fb0[4], fb1[4];
#pragma unroll
                for (int ks = 0; ks < 4; ++ks) { fa0[ks] = *(const LAS bf16x8*)(ka + ks * 64); fa1[ks] = *(const LAS bf16x8*)(ka + 16 * HG_QROW + ks * 64); fb0[ks] = *(const LAS bf16x8*)(qa + ks * 64); fb1[ks] = *(const LAS bf16x8*)(qa + 16 * HG_QROW + ks * 64); }
                __builtin_amdgcn_sched_barrier(0);
#pragma unroll
                for (int ks = 0; ks < 4; ++ks) { c00 = __builtin_amdgcn_mfma_f32_16x16x32_bf16(fa0[ks], fb0[ks], c00, 0, 0, 0); c01 = __builtin_amdgcn_mfma_f32_16x16x32_bf16(fa0[ks], fb1[ks], c01, 0, 0, 0); c11 = __builtin_amdgcn_mfma_f32_16x16x32_bf16(fa1[ks], fb1[ks], c11, 0, 0, 0); } }
            f32x4 ea[4], eb4[4]; bf16x8 qa0[4], qa1[4];
            {   const LAS unsigned char* qa = set + HG_QD + l15 * HG_QROW + quad * 8; const LAS float* er = (const LAS float*)(set + HG_ER) + 4 * quad;
#pragma unroll
                for (int ks = 0; ks < 4; ++ks) { ea[ks] = *(const LAS f32x4*)(er + 32 * ks); eb4[ks] = *(const LAS f32x4*)(er + 32 * ks + 16);
                    const s16x4 a0l = *(const LAS s16x4*)(qa + ks * 64), a0h = *(const LAS s16x4*)(qa + ks * 64 + 32), a1l = *(const LAS s16x4*)(qa + 16 * HG_QROW + ks * 64), a1h = *(const LAS s16x4*)(qa + 16 * HG_QROW + ks * 64 + 32);
                    qa0[ks] = __builtin_shufflevector(a0l, a0h, 0, 1, 2, 3, 4, 5, 6, 7); qa1[ks] = __builtin_shufflevector(a1l, a1h, 0, 1, 2, 3, 4, 5, 6, 7); } }
            __builtin_amdgcn_sched_barrier(0);
#pragma unroll
            for (int j = 0; j < 4; ++j) { if (4 * quad + j > l15) { c00[j] = 0.f; c11[j] = 0.f; } }
            const v4u sa0 = {cvtpk(c00[0], c00[1]), cvtpk(c00[2], c00[3]), 0u, 0u}, sa1 = {cvtpk(c01[0], c01[1]), cvtpk(c01[2], c01[3]), cvtpk(c11[0], c11[1]), cvtpk(c11[2], c11[3])};
            f32x4 o[2][2];
#pragma unroll
            for (int j = 0; j < 2; ++j) { o[j][0] = (f32x4){0.f, 0.f, 0.f, 0.f}; o[j][1] = o[j][0]; }
#pragma unroll
            for (int ks = 0; ks < 4; ++ks)
#pragma unroll
                for (int j = 0; j < 2; ++j) { const f32x4 sa = S[j][2 * ks] * ea[ks], sb = S[j][2 * ks + 1] * eb4[ks];
                    const v4u bw = {cvtpk(sa[0], sa[1]), cvtpk(sa[2], sa[3]), cvtpk(sb[0], sb[1]), cvtpk(sb[2], sb[3])};
                    o[j][0] = __builtin_amdgcn_mfma_f32_16x16x32_bf16(qa0[ks], __builtin_bit_cast(bf16x8, bw), o[j][0], 0, 0, 0);
                    o[j][1] = __builtin_amdgcn_mfma_f32_16x16x32_bf16(qa1[ks], __builtin_bit_cast(bf16x8, bw), o[j][1], 0, 0, 0); }
            int oo_ = HG_OST + (ch & 1) * HG_OSTB; asm volatile("" : "+s"(oo_)); LAS float* ost = (LAS float*)(lds + oo_);
            bf16x8 k2f[8]; f32x4 d4[8]; bf16x8 ivp[2], ivn[2];
            {   const LAS float* eb = (const LAS float*)(set + HG_EB) + 4 * quad; const LAS unsigned char* k2a = set + HG_K2 + l15 * HG_TROW + quad * 16;
#pragma unroll
                for (int mt = 0; mt < 8; ++mt) { d4[mt] = *(const LAS f32x4*)(eb + 16 * mt); k2f[mt] = *(const LAS bf16x8*)(k2a + mt * 16 * HG_TROW); }
#pragma unroll
                for (int j = 0; j < 2; ++j) { const LAS unsigned char* ivr = set + HG_IV + (32 * m + 16 * j + l15) * HG_TROW;
                    const s16x4 pl = *(const LAS s16x4*)(ivr + quad * 8), ph = *(const LAS s16x4*)(ivr + 32 + quad * 8); ivp[j] = __builtin_shufflevector(pl, ph, 0, 1, 2, 3, 4, 5, 6, 7); ivn[j] = *(const LAS bf16x8*)(ivr + quad * 16); } }
            __builtin_amdgcn_sched_barrier(0);
#pragma unroll
            for (int j = 0; j < 2; ++j) {
                o[j][0] = __builtin_amdgcn_mfma_f32_16x16x32_bf16(__builtin_bit_cast(bf16x8, sa0), ivp[j], o[j][0], 0, 0, 0); o[j][1] = __builtin_amdgcn_mfma_f32_16x16x32_bf16(__builtin_bit_cast(bf16x8, sa1), ivp[j], o[j][1], 0, 0, 0);
#pragma unroll
                for (int mt = 0; mt < 8; ++mt) S[j][mt] = __builtin_amdgcn_mfma_f32_16x16x32_bf16(k2f[mt], ivn[j], S[j][mt] * d4[mt], 0, 0, 0);
            }
#pragma unroll
            for (int j = 0; j < 2; ++j)
#pragma unroll
                for (int jj = 0; jj < 4; ++jj) { ost[(4 * quad + jj) * HG_OROW + 32 * m + 16 * j + l15] = o[j][0][jj]; ost[(16 + 4 * quad + jj) * HG_OROW + 32 * m + 16 * j + l15] = o[j][1][jj]; }
            __syncthreads();
        }
    }
    __syncthreads();
}

typedef float f32x16 __attribute__((ext_vector_type(16)));
constexpr int AT_KROW = 200  , AT_VROW = 72  , AT_KB = 64 * AT_KROW, AT_VB = 128 * AT_VROW;
constexpr int AT_OST = 2 * (AT_KB + AT_VB) + 1024;
static_assert(2 * (AT_KB + AT_VB) <= RING_BYTES && AT_OST % 16 == 0 && AT_OST + 8 * 32 * 272 <= LDSCTL_OFF, "attention LDS");
__device__ __forceinline__ int crow(int r, int hi) { return (r & 3) + 8 * (r >> 2) + 4 * hi; }
struct AttnPre { pg8::u32x2 q8[12]; v4u st[5]; };
__device__ __forceinline__ void attn_prefetch(const Args& A, int b, int h, int qb, int tid, AttnPre& P, bool with_q = true, bool with_st = true) {
    asm volatile("" : "+v"(tid));
    const int lane = tid & 63, wid = __builtin_amdgcn_readfirstlane(tid >> 6), r32 = lane & 31, hi = lane >> 5;
    const bf16* qbuf = (const bf16*)(A.ws + WS_BIG); const bf16* ckv = (const bf16*)(A.ws + WS_CKV); const bf16* ckvT = (const bf16*)(A.ws + WS_CKVT);
    const size_t tokq = (size_t)b * SEQ + qb * 256 + wid * 32 + r32, tok0 = (size_t)b * SEQ;
    const unsigned char* Qp = (const unsigned char*)qbuf + ((tokq >> 4) * 96 + 6 * h) * 512 + (tokq & 15) * 32 + hi * 8;
    if (with_q) {
#pragma unroll
    for (int s = 0; s < 12; ++s) P.q8[s] = *(const GAS pg8::u32x2*)(Qp + (s >> 1) * 512 + (s & 1) * 16); }
    const bf16* kp = ckv + (tok0 + (tid >> 3)) * 256 + (tid & 7) * 8; const bf16* vp = ckvT + (size_t)(tid >> 2) * T + tok0 + (tid & 3) * 8;
    if (with_st) { P.st[0] = *(const GAS v4u*)(kp); P.st[1] = *(const GAS v4u*)(kp + 64); P.st[2] = *(const GAS v4u*)(kp + 128); P.st[3] = *(const GAS v4u*)(vp); P.st[4] = *(const GAS v4u*)(vp + 32); }
}
__device__ __forceinline__ void attn_unit(const Args& A, int b, int h, int qb, LAS unsigned char* lds, int tid, AttnPre& P, bool has_next, int nb, int nh, int nqb, bool st_ready) {
    asm volatile("" : "+v"(tid));
    const int lane = tid & 63, wid = __builtin_amdgcn_readfirstlane(tid >> 6), r32 = lane & 31, hi = lane >> 5;
    const bf16* qbuf = (const bf16*)(A.ws + WS_BIG); const bf16* ckv = (const bf16*)(A.ws + WS_CKV); const bf16* ckvT = (const bf16*)(A.ws + WS_CKVT);
    bf16* obuf = (bf16*)(A.ws + WS_ABUF);
    const int q0 = qb * 256, qrow = q0 + wid * 32 + r32; const size_t tokq = (size_t)b * SEQ + qrow;
    f32x16 o[4];
#pragma unroll
    for (int d = 0; d < 4; ++d)
#pragma unroll
        for (int i = 0; i < 16; ++i) o[d][i] = 0.f;
    float m_run = -1e30f, l_run = 0.f;
    const int NT = 4 * qb + 4;
    v4u st[5];
#pragma unroll
    for (int i = 0; i < 5; ++i) st[i] = (v4u){0u, 0u, 0u, 0u};
    const size_t tok0 = (size_t)b * SEQ;
    const unsigned char* kp = A.ws + WS_CK8 + (tok0 + (tid >> 3)) * 192 + (tid & 7) * 8;
    pg8::u32x2 k8[3];
    const unsigned char* vp = A.ws + WS_CVT8 + (size_t)(tid >> 2) * T + tok0 + (tid & 3) * 16;
    { k8[0] = *(const GAS pg8::u32x2*)(kp); k8[1] = *(const GAS pg8::u32x2*)(kp + 64); k8[2] = *(const GAS pg8::u32x2*)(kp + 128); st[3] = *(const GAS v4u*)(vp); kp += 64 * 192; vp += 64; }
    const int kdst = (tid >> 3) * AT_KROW + (tid & 7) * 8, vdst = AT_KB + (tid >> 2) * AT_VROW + (tid & 3) * 16; (void)ckvT; (void)ckv;
#define AT_LOAD(t) do { k8[0] = *(const GAS pg8::u32x2*)(kp); k8[1] = *(const GAS pg8::u32x2*)(kp + 64); k8[2] = *(const GAS pg8::u32x2*)(kp + 128); st[3] = *(const GAS v4u*)(vp); \
        kp += 64 * 192; vp += 64; } while (0)
#define AT_STORE(buf) do { LAS unsigned char* bb_ = lds + (buf) * (AT_KB + AT_VB); \
        *(LAS pg8::u32x2*)(bb_ + kdst) = k8[0]; *(LAS pg8::u32x2*)(bb_ + kdst + 64) = k8[1]; *(LAS pg8::u32x2*)(bb_ + kdst + 128) = k8[2]; typedef unsigned u2_ __attribute__((ext_vector_type(2)));   \
        *(LAS u2_*)(bb_ + vdst) = (u2_){st[3].x, st[3].y}; *(LAS u2_*)(bb_ + vdst + 8) = (u2_){st[3].z, st[3].w}; } while (0)
    AT_STORE(0);
    __builtin_amdgcn_sched_barrier(0);
    long qf[12];
#pragma unroll
    for (int s = 0; s < 12; ++s) qf[s] = __builtin_bit_cast(long, P.q8[s]);
    __syncthreads();
    for (int t = 0; t < NT; ++t) {
        const int buf = t & 1;
        if (t + 1 < NT) AT_LOAD(t + 1);
        if (64 * t <= q0 + wid * 32 + 31) {
            const LAS unsigned char* kb = lds + buf * (AT_KB + AT_VB) + r32 * AT_KROW + hi * 8;
            f32x16 s0, s1;
#pragma unroll
            for (int i = 0; i < 16; ++i) { s0[i] = 0.f; s1[i] = 0.f; }
#pragma unroll
            for (int sb4 = 0; sb4 < 12; sb4 += 4) { long ka[4], kc[4];
#pragma unroll
                for (int s = 0; s < 4; ++s) { ka[s] = *(const LAS long*)(kb + (sb4 + s) * 16); kc[s] = *(const LAS long*)(kb + 32 * AT_KROW + (sb4 + s) * 16); }
                __builtin_amdgcn_sched_barrier(0);
#pragma unroll
                for (int s = 0; s < 4; ++s) { s0 = __builtin_amdgcn_mfma_f32_32x32x16_fp8_fp8(ka[s], qf[sb4 + s], s0, 0, 0, 0); s1 = __builtin_amdgcn_mfma_f32_32x32x16_fp8_fp8(kc[s], qf[sb4 + s], s1, 0, 0, 0); }
                __builtin_amdgcn_sched_barrier(0); }
            if (64 * t + 63 > q0 + wid * 32) {
#pragma unroll
                for (int i = 0; i < 16; ++i) { const int key = 64 * t + crow(i, hi); if (key > qrow) s0[i] = -__builtin_inff(); if (key + 32 > qrow) s1[i] = -__builtin_inff(); }
            }
            float mx = s0[0];
#pragma unroll
            for (int i = 1; i < 16; ++i) mx = fmaxf(mx, s0[i]);
#pragma unroll
            for (int i = 0; i < 16; ++i) mx = fmaxf(mx, s1[i]);
            mx = fmaxf(mx, __shfl_xor(mx, 32)); constexpr float usc = 1.0f / (pg8::Q_SC * pg8::K_SC); mx *= usc;
            if (__any(mx > m_run + 8.0f)) {
                const float mn = fmaxf(m_run, mx), alpha = __builtin_amdgcn_exp2f(m_run - mn); m_run = mn; l_run *= alpha;
#pragma unroll
                for (int d = 0; d < 4; ++d)
#pragma unroll
                    for (int i = 0; i < 16; ++i) o[d][i] *= alpha; }
#pragma unroll
            for (int i = 0; i < 16; ++i) { s0[i] = __builtin_amdgcn_exp2f(__builtin_fmaf(s0[i], usc, -m_run)); s1[i] = __builtin_amdgcn_exp2f(__builtin_fmaf(s1[i], usc, -m_run)); }
            long pb[4]; float ps = 0.f;
#pragma unroll
            for (int s2 = 0; s2 < 2; ++s2) { pg8::u32x2 w0, w1;
                w0.x = __builtin_amdgcn_cvt_pk_bf8_f32(s0[8 * s2 + 0], s0[8 * s2 + 1], 0u, false); w0.x = __builtin_amdgcn_cvt_pk_bf8_f32(s0[8 * s2 + 2], s0[8 * s2 + 3], w0.x, true);
                w0.y = __builtin_amdgcn_cvt_pk_bf8_f32(s0[8 * s2 + 4], s0[8 * s2 + 5], 0u, false); w0.y = __builtin_amdgcn_cvt_pk_bf8_f32(s0[8 * s2 + 6], s0[8 * s2 + 7], w0.y, true);
                w1.x = __builtin_amdgcn_cvt_pk_bf8_f32(s1[8 * s2 + 0], s1[8 * s2 + 1], 0u, false); w1.x = __builtin_amdgcn_cvt_pk_bf8_f32(s1[8 * s2 + 2], s1[8 * s2 + 3], w1.x, true);
                w1.y = __builtin_amdgcn_cvt_pk_bf8_f32(s1[8 * s2 + 4], s1[8 * s2 + 5], 0u, false); w1.y = __builtin_amdgcn_cvt_pk_bf8_f32(s1[8 * s2 + 6], s1[8 * s2 + 7], w1.y, true);
                const unsigned ws_[4] = {w0.x, w0.y, w1.x, w1.y};
#pragma unroll
                for (int q = 0; q < 4; ++q) { const f32x2_t a = __builtin_amdgcn_cvt_pk_f32_bf8(ws_[q], false), c2 = __builtin_amdgcn_cvt_pk_f32_bf8(ws_[q], true); ps += (a.x + a.y) + (c2.x + c2.y); }
                pb[s2] = __builtin_bit_cast(long, w0); pb[2 + s2] = __builtin_bit_cast(long, w1); }
            l_run += ps;
            const LAS unsigned char* vb = lds + buf * (AT_KB + AT_VB) + AT_KB + r32 * AT_VROW + hi * 4;
#pragma unroll
            for (int dp = 0; dp < 4; dp += 2) { long vf[2][4];
#pragma unroll
                for (int d2 = 0; d2 < 2; ++d2)
#pragma unroll
                    for (int ks = 0; ks < 4; ++ks) { const unsigned lo = *(const LAS unsigned*)(vb + (dp + d2) * 32 * AT_VROW + ks * 16), hh = *(const LAS unsigned*)(vb + (dp + d2) * 32 * AT_VROW + ks * 16 + 8);
                        vf[d2][ks] = (long)(((unsigned long long)hh << 32) | lo); }
                __builtin_amdgcn_sched_barrier(0);
#pragma unroll
                for (int ks = 0; ks < 4; ++ks)
#pragma unroll
                    for (int d2 = 0; d2 < 2; ++d2) o[dp + d2] = __builtin_amdgcn_mfma_f32_32x32x16_fp8_bf8(vf[d2][ks], pb[ks], o[dp + d2], 0, 0, 0);
                __builtin_amdgcn_sched_barrier(0); }
        }
        if (t + 1 < NT) AT_STORE(buf ^ 1);
        __syncthreads();
    }
#undef AT_LOAD
#undef AT_STORE
    if (has_next) attn_prefetch(A, nb, nh, nqb, tid, P, true, false);
    const float lt = l_run + __shfl_xor(l_run, 32), inv = 1.0f / lt;
    LAS unsigned char* stg = lds + AT_OST + wid * (32 * 272);
    const float inv8 = inv * (pg8::OB_SC / pg8::K_SC);
#pragma unroll
    for (int d = 0; d < 4; ++d)
#pragma unroll
        for (int g = 0; g < 4; ++g) { unsigned w = __builtin_amdgcn_cvt_pk_fp8_f32(o[d][4 * g] * inv8, o[d][4 * g + 1] * inv8, 0u, false); w = __builtin_amdgcn_cvt_pk_fp8_f32(o[d][4 * g + 2] * inv8, o[d][4 * g + 3] * inv8, w, true);
            *(LAS unsigned*)(stg + r32 * 144 + (32 * d + 8 * g + 4 * hi)) = w; }
    asm volatile("s_waitcnt lgkmcnt(0)" ::: "memory");
    { unsigned char* ob = (unsigned char*)obuf + ((size_t)b * SEQ + q0 + wid * 32 + (lane >> 3)) * 2048 + h * 128 + (lane & 7) * 16;
#pragma unroll
      for (int i4 = 0; i4 < 4; ++i4) { const v4u v = *(const LAS v4u*)(stg + (i4 * 8 + (lane >> 3)) * 144 + (lane & 7) * 16); *(GAS v4u*)(ob + (size_t)i4 * 8 * 2048) = v; } }
}

__device__ __forceinline__ int moe_tables(const Args& A, int layer, LAS unsigned char* lds, int tid) {
    LAS int* tstart = (LAS int*)(lds + TAB_TSTART); LAS unsigned char* tile_e = lds + TAB_TILEE;
    const unsigned* cnt = (const unsigned*)(A.ws + WS_CTL) + CW_CNT + layer * NE * 16;
    LAS int* lcn = (LAS int*)(lds + TAB_LCNT);
    if (tid < NE) lcn[tid] = (int)__hip_atomic_load(cnt + tid * 16, RLX_AGENT);
    __syncthreads();
    if (tid == 0) { int acc = 0; for (int e = 0; e < NE; ++e) { tstart[e] = acc; acc += (lcn[e] + 255) >> 8; } tstart[NE] = acc; }
    __syncthreads();
    if (tid < NE) { const int s = tstart[tid], e2 = tstart[tid + 1]; for (int i = s; i < e2; ++i) tile_e[i] = (unsigned char)tid; }
    __syncthreads();
    return tstart[NE];
}

__device__ __forceinline__ void ln_row(f32x4 (&v)[4], const f32x4 (&g)[4], const f32x4 (&bb)[4]) {
    float s = 0.f;
#pragma unroll
    for (int j = 0; j < 4; ++j) s += (v[j].x + v[j].y) + (v[j].z + v[j].w);
    const float mean = wave_sum(s) * (1.f / D); float s2 = 0.f;
#pragma unroll
    for (int j = 0; j < 4; ++j) { v[j] = v[j] - mean; s2 += (v[j].x * v[j].x + v[j].y * v[j].y) + (v[j].z * v[j].z + v[j].w * v[j].w); }
    const float rstd = 1.f / sqrtf(wave_sum(s2) * (1.f / D) + LN_EPS);
#pragma unroll
    for (int j = 0; j < 4; ++j) v[j] = v[j] * rstd * g[j] + bb[j];
}

#define IN(k) (lo <= (k) && (k) < hi)
#define REPEAT(loc) for (int rep_ = ((layer == REP_LAYER && ((REP_MASK >> (loc)) & 1)) ? 0 : 1); rep_ < 2; ++rep_)
#define OPQ() int tid = tid_of(wave_s); asm volatile("" : "+v"(tid)); const int lane = tid & 63, wave = __builtin_amdgcn_readfirstlane(tid >> 6); (void)lane; (void)wave; OPQW()
#define OPQW() unsigned char* ws = A.ws; asm volatile("" : "+s"(ws)); gu32* ctl = (gu32*)(ws + WS_CTL); bf16* xb = (bf16*)(ws + WS_XB); bf16* tbuf = (bf16*)(ws + WS_TBUF); (void)ctl; (void)xb; (void)tbuf
#define SEAM() do { if (A.single) xcd_barrier(bar); } while (0)

template <int layer> __device__ __forceinline__ void run_layer(const Args& A, LAS unsigned char* lds, const XcdBarrier& bar, const int G, const int bx, const int vcu, const int lo, const int hi, const int wave_s) {
        const int sb = 1 + layer * 16;
        if constexpr (layer < N_A) {
            if (IN(sb + 0)) REPEAT(0) {
                OPQW();
                pg8::Gemm g{(const bf16*)(ws + WS_X8), (const bf16*)(ws + WS_HGWIN) + (size_t)layer * 4096 * 512, T, 4096, 512}; pg8::StaticOrder S; S.init(T, 4096, G, bx);
                pg8::EpiHgIn E{(bf16*)(ws + WS_BIG), (const float*)(ws + WS_LBTAB) + layer * 1024};
                pg8::gemm_phase<pg8::EpiHgIn, pg8::StaticOrder, true, true>(lds + RING_OFF, g, S, E, wave_s); SEAM();
            }
            if (IN(sb + 1)) REPEAT(1) {
                OPQ();
                for (int u = vcu; u < BATCH * HGH; u += G) hg_chunk_unit(A, layer, u, lds, tid);
                SEAM();
            }
        } else {
            const int j = layer - N_A;
            if constexpr (layer == N_A) {
                if (IN(sb + 0)) REPEAT(0) {
                OPQW();
                    pg8::Gemm g{xb, (const bf16*)(ws + WS_KVA), T, 256, 1024}; pg8::StaticOrder S; S.init(T, 256, G, bx);
                    pg8::EpiKva E{(bf16*)(ws + WS_CKV), (const float*)(ws + WS_ROPE)};
                    pg8::gemm_phase<pg8::EpiKva, pg8::StaticOrder, true, true>(lds + RING_OFF, g, S, E, wave_s); SEAM();
                }
                if (IN(sb + 1)) REPEAT(1) {
                OPQ();
                    bf16* ckv = (bf16*)(ws + WS_CKV); bf16* ckvT = (bf16*)(ws + WS_CKVT); const int sub = lane & 15; const f32x4 g0 = *(const f32x4*)(A.kv_norm + sub * 8), g1 = *(const f32x4*)(A.kv_norm + sub * 8 + 4);
                    LAS unsigned short* tl = (LAS unsigned short*)lds;
                    for (int c0 = vcu * 256; c0 < T; c0 += G * 256) {
                        for (int rr = tid >> 4; rr < 256; rr += NTHR >> 4) { GAS v4u* p = (GAS v4u*)(ckv + (size_t)(c0 + rr) * 256 + sub * 8); const v4u w = *p;
                            float f[8] = {bflo(w.x), bfhi(w.x), bflo(w.y), bfhi(w.y), bflo(w.z), bfhi(w.z), bflo(w.w), bfhi(w.w)}; float ss = 0.f;
#pragma unroll
                            for (int i = 0; i < 8; ++i) ss += f[i] * f[i];
                            ss += __shfl_xor(ss, 1); ss += __shfl_xor(ss, 2); ss += __shfl_xor(ss, 4); ss += __shfl_xor(ss, 8);
                            const float rs = 1.0f / sqrtf(ss * (1.0f / 128.0f) + RMS_EPS);
                            const v4u o = {cvtpk(f[0] * rs * g0[0], f[1] * rs * g0[1]), cvtpk(f[2] * rs * g0[2], f[3] * rs * g0[3]), cvtpk(f[4] * rs * g1[0], f[5] * rs * g1[1]), cvtpk(f[6] * rs * g1[2], f[7] * rs * g1[3])};
                            *p = o; const unsigned ow[4] = {o.x, o.y, o.z, o.w};
                            {   unsigned char* k8 = ws + WS_CK8 + (size_t)(c0 + rr) * 192; constexpr float ks = pg8::K_SC; pg8::u32x2 w8;
                                w8.x = __builtin_amdgcn_cvt_pk_fp8_f32(f[0] * rs * g0[0] * ks, f[1] * rs * g0[1] * ks, 0u, false); w8.x = __builtin_amdgcn_cvt_pk_fp8_f32(f[2] * rs * g0[2] * ks, f[3] * rs * g0[3] * ks, w8.x, true);
                                w8.y = __builtin_amdgcn_cvt_pk_fp8_f32(f[4] * rs * g1[0] * ks, f[5] * rs * g1[1] * ks, 0u, false); w8.y = __builtin_amdgcn_cvt_pk_fp8_f32(f[6] * rs * g1[2] * ks, f[7] * rs * g1[3] * ks, w8.y, true);
                                *(GAS pg8::u32x2*)(k8 + sub * 8) = w8;
                                const pg8::u32x2 rp = *(const GAS pg8::u32x2*)(ckv + (size_t)(c0 + rr) * 256 + 128 + sub * 4);
                                unsigned r8 = __builtin_amdgcn_cvt_pk_fp8_f32(bflo(rp.x) * ks, bfhi(rp.x) * ks, 0u, false); r8 = __builtin_amdgcn_cvt_pk_fp8_f32(bflo(rp.y) * ks, bfhi(rp.y) * ks, r8, true);
                                *(GAS unsigned*)(k8 + 128 + sub * 4) = r8; }
#pragma unroll
                            for (int i = 0; i < 4; ++i) { tl[(sub * 8 + 2 * i) * 264 + rr] = (unsigned short)(ow[i] & 0xffffu); tl[(sub * 8 + 2 * i + 1) * 264 + rr] = (unsigned short)(ow[i] >> 16); } }
                        __syncthreads();
                        for (int q = tid; q < 128 * 32; q += NTHR) { const int d = q >> 5, ch = q & 31; const v4u w = *(const LAS v4u*)(tl + d * 264 + ch * 8); constexpr float ks = pg8::K_SC; pg8::u32x2 w8;
                            w8.x = __builtin_amdgcn_cvt_pk_fp8_f32(bflo(w.x) * ks, bfhi(w.x) * ks, 0u, false); w8.x = __builtin_amdgcn_cvt_pk_fp8_f32(bflo(w.y) * ks, bfhi(w.y) * ks, w8.x, true);
                            w8.y = __builtin_amdgcn_cvt_pk_fp8_f32(bflo(w.z) * ks, bfhi(w.z) * ks, 0u, false); w8.y = __builtin_amdgcn_cvt_pk_fp8_f32(bflo(w.w) * ks, bfhi(w.w) * ks, w8.y, true);
                            *(GAS pg8::u32x2*)(ws + WS_CVT8 + (size_t)d * T + c0 + ch * 8) = w8; (void)ckvT; }
                        __syncthreads();
                    }
                    SEAM();
                }
            }
            if (IN(sb + 4)) REPEAT(4) {
                OPQW();
                pg8::Gemm g{xb, (const bf16*)(ws + WS_DQ) + (size_t)j * 256 * 1024, T, 256, 1024}; pg8::StaticOrder S; S.init(T, 256, G, bx); pg8::EpiPlain E{(bf16*)(ws + WS_CQ), 256, 1.0f};
                pg8::gemm_phase<pg8::EpiPlain, pg8::StaticOrder, true, true>(lds + RING_OFF, g, S, E, wave_s); SEAM();
            }
            if (IN(sb + 5)) REPEAT(5) {
                OPQ();
                bf16* cq = (bf16*)(ws + WS_CQ); const int sub = lane & 31; const f32x4 g0 = *(const f32x4*)(A.mla_q_norm + j * 256 + sub * 8), g1 = *(const f32x4*)(A.mla_q_norm + j * 256 + sub * 8 + 4);
                for (int r = (vcu * NTHR + tid) >> 5; r < T; r += (G * NTHR) >> 5) { GAS v4u* p = (GAS v4u*)(cq + (size_t)r * 256 + sub * 8); const v4u w = *p;
                    float f[8] = {bflo(w.x), bfhi(w.x), bflo(w.y), bfhi(w.y), bflo(w.z), bfhi(w.z), bflo(w.w), bfhi(w.w)}; float ss = 0.f;
#pragma unroll
                    for (int i = 0; i < 8; ++i) ss += f[i] * f[i];
                    ss += __shfl_xor(ss, 1); ss += __shfl_xor(ss, 2); ss += __shfl_xor(ss, 4); ss += __shfl_xor(ss, 8); ss += __shfl_xor(ss, 16);
                    const float rs = 1.0f / sqrtf(ss * (1.0f / 256.0f) + RMS_EPS);
                    *p = (v4u){cvtpk(f[0] * rs * g0[0], f[1] * rs * g0[1]), cvtpk(f[2] * rs * g0[2], f[3] * rs * g0[3]), cvtpk(f[4] * rs * g1[0], f[5] * rs * g1[1]), cvtpk(f[6] * rs * g1[2], f[7] * rs * g1[3])}; }
                SEAM();
            }
            if (IN(sb + 6)) REPEAT(6) {
                OPQW();
                pg8::Gemm g{(const bf16*)(ws + WS_CQ), (const bf16*)(ws + WS_UQ) + (size_t)j * 3072 * 256, T, 3072, 256}; pg8::StaticOrder S; S.init(T, 3072, G, bx);
                pg8::EpiUq E{(bf16*)(ws + WS_BIG), (const float*)(ws + WS_ROPE), QSCALE};
                pg8::gemm_phase<pg8::EpiUq, pg8::StaticOrder, true, true>(lds + RING_OFF, g, S, E, wave_s); SEAM();
            }
            if (IN(sb + 7)) REPEAT(7) {
                OPQ();
                if (vcu < BATCH * MH) { AttnPre pre; attn_prefetch(A, vcu / MH, vcu % MH, 7, tid, pre, true, false);
                    for (int u = vcu; u < BATCH * MH; u += G) { const int b = u / MH, h = u % MH;
                        for (int qb = 7; qb >= 0; --qb) { const bool nx = qb > 0 || u + G < BATCH * MH; const int nu = qb > 0 ? u : u + G; attn_unit(A, b, h, qb, lds, tid, pre, nx, nu / MH, nu % MH, qb > 0 ? qb - 1 : 7, false); } } }
                SEAM();
            }
        }
        if (IN(sb + 8)) REPEAT(8) {
                OPQW();
            pg8::StaticOrder S; S.init(T, 1024, G, bx);
            if constexpr (layer < N_A) { pg8::Gemm g{(const bf16*)(ws + WS_ABUF), (const bf16*)(ws + WS_HGWO) + (size_t)layer * 1024 * 1024, T, 1024, 1024}; pg8::EpiResT<false> E{xb, tbuf, DN_ALPHA, 1.0f};
                pg8::gemm_phase<pg8::EpiResT<false>, pg8::StaticOrder, true, true>(lds + RING_OFF, g, S, E, wave_s); }
            else { pg8::Gemm g{(const bf16*)(ws + WS_ABUF), (const bf16*)(ws + WS_MWO) + (size_t)(layer - N_A) * 1024 * 1024, T, 1024, 1024};
                pg8::EpiResT<true> E{xb, tbuf, DN_ALPHA, 1.0f / (pg8::MWO_SC * pg8::OB_SC)};
                pg8::gemm_phase<pg8::EpiResT<true>, pg8::StaticOrder, true, true>(lds + RING_OFF, g, S, E, wave_s); }
            SEAM();
        }
        if (IN(sb + 9)) REPEAT(9) {
                OPQ();
            LAS unsigned char* Whi = lds + R1_WHI; LAS unsigned char* Wlo = lds + R1_WLO; LAS float* stat = (LAS float*)(lds + R1_STAT); LAS float* S1 = (LAS float*)(lds + R1_S12); LAS float* S2 = S1 + 32; LAS float* red = (LAS float*)(lds + R1_RED);
            LAS int* lcnt = (LAS int*)(lds + TAB_LCNT); LAS int* lbase = (LAS int*)(lds + TAB_LBASE); LAS int* a_e = (LAS int*)(lds + TAB_AE); LAS int* a_rank = (LAS int*)(lds + TAB_ARANK); LAS float* a_g = (LAS float*)(lds + TAB_AG);
            {
                const unsigned char* img = ws + WS_RIMG + (size_t)layer * RIMG_STRIDE; (void)red;
#pragma unroll
                for (int i = 0; i < 16; ++i) { const int idx = wave * 16 + i, row = idx >> 1, half = idx & 1;
                    __builtin_amdgcn_global_load_lds((const unsigned*)(img + (size_t)row * 2048 + half * 1024 + lane * 16), (LAS unsigned*)(lds + (row < 32 ? R1_WHI + row * R1_WROW : R1_WLO + (row - 32) * R1_WROW) + half * 1024), 16, 0, 0); }
                if (tid < 64) S1[tid] = *(const GAS float*)(img + 131072 + tid * 4);
                if (tid < NE) lcnt[tid] = 0;
                asm volatile("s_waitcnt vmcnt(0)" ::: "memory");
                __syncthreads(); }
            f32x4 gv[4], bv[4];
#pragma unroll
            for (int jj = 0; jj < 4; ++jj) { gv[jj] = *(const f32x4*)(A.ln_g + (size_t)(layer * 2 + 0) * D + 4 * lane + 256 * jj); bv[jj] = *(const f32x4*)(A.ln_b + (size_t)(layer * 2 + 0) * D + 4 * lane + 256 * jj); }
            const int chunk = T / G, wbase = vcu * chunk;
            for (int w0 = wave * 32; w0 < chunk; w0 += NWAVES * 32) {
                unsigned long long rw_[4][4], rn_[4][4];
#pragma unroll
                for (int tt = 0; tt < 4; ++tt)
#pragma unroll
                    for (int jj = 0; jj < 4; ++jj) rw_[tt][jj] = *(const GAS unsigned long long*)(tbuf + (size_t)(wbase + w0 + tt) * D + 4 * lane + 256 * jj);
                for (int p = 0; p < 32; p += 4) {
                    if (p + 4 < 32) {
#pragma unroll
                        for (int tt = 0; tt < 4; ++tt)
#pragma unroll
                            for (int jj = 0; jj < 4; ++jj) rn_[tt][jj] = *(const GAS unsigned long long*)(tbuf + (size_t)(wbase + w0 + p + 4 + tt) * D + 4 * lane + 256 * jj); }
#pragma unroll
                    for (int tt = 0; tt < 4; ++tt) { const size_t m = (size_t)(wbase + w0 + p + tt);
                        f32x4 xr[4];
#pragma unroll
                        for (int jj = 0; jj < 4; ++jj) { const unsigned wl = (unsigned)rw_[tt][jj], wh = (unsigned)(rw_[tt][jj] >> 32); xr[jj] = (f32x4){bflo(wl), bfhi(wl), bflo(wh), bfhi(wh)}; }
                        float s = 0.f;
#pragma unroll
                        for (int jj = 0; jj < 4; ++jj) s += (xr[jj].x + xr[jj].y) + (xr[jj].z + xr[jj].w);
                        const float mean = wave_sum(s) * (1.f / D); float s2 = 0.f;
#pragma unroll
                        for (int jj = 0; jj < 4; ++jj) { const f32x4 d = xr[jj] - mean; s2 += (d.x * d.x + d.y * d.y) + (d.z * d.z + d.w * d.w); }
                        const float rstd = 1.f / sqrtf(wave_sum(s2) * (1.f / D) + LN_EPS);
                        if (lane == 0) { stat[(w0 + p + tt) * 2] = mean; stat[(w0 + p + tt) * 2 + 1] = rstd; *(GAS f32x2_t*)(ws + WS_STATS + m * 8) = (f32x2_t){mean, rstd}; }
#pragma unroll
                        for (int jj = 0; jj < 4; ++jj) { const f32x4 y = (xr[jj] - mean) * rstd * gv[jj] + bv[jj];
                            *(GAS unsigned*)(ws + WS_X8 + m * D + 4 * lane + 256 * jj) = __builtin_amdgcn_cvt_pk_fp8_f32(y.z, y.w, __builtin_amdgcn_cvt_pk_fp8_f32(y.x, y.y, 0u, false), true); } }
#pragma unroll
                    for (int tt = 0; tt < 4; ++tt)
#pragma unroll
                        for (int jj = 0; jj < 4; ++jj) rw_[tt][jj] = rn_[tt][jj];
                }
                const int r32 = lane & 31, hh = lane >> 5;
                f32x16 acc;
#pragma unroll
                for (int i = 0; i < 16; ++i) acc[i] = 0.f;
                {   const bf16* tp = tbuf + (size_t)(wbase + w0 + r32) * D + 8 * hh; const LAS unsigned char* wh = Whi + r32 * R1_WROW + hh * 16; const LAS unsigned char* wl = Wlo + r32 * R1_WROW + hh * 16;
#pragma unroll 8
                    for (int s_ = 0; s_ < 64; ++s_) { const bf16x8 bt = *(const GAS bf16x8*)(tp + 16 * s_);
                        acc = __builtin_amdgcn_mfma_f32_32x32x16_bf16(*(const LAS bf16x8*)(wh + 32 * s_), bt, acc, 0, 0, 0);
                        acc = __builtin_amdgcn_mfma_f32_32x32x16_bf16(*(const LAS bf16x8*)(wl + 32 * s_), bt, acc, 0, 0, 0); } }
                asm volatile("s_waitcnt lgkmcnt(0)" ::: "memory");
                const float mu = stat[(w0 + r32) * 2], rs = stat[(w0 + r32) * 2 + 1];
                float lv[16];
#pragma unroll
                for (int g4 = 0; g4 < 4; ++g4) { const f32x4 a1 = *(const LAS f32x4*)(S1 + 8 * g4 + 4 * hh), a2 = *(const LAS f32x4*)(S2 + 8 * g4 + 4 * hh);
#pragma unroll
                    for (int q = 0; q < 4; ++q) lv[4 * g4 + q] = rs * (acc[4 * g4 + q] - mu * a1[q]) + a2[q]; }
                float cv[8]; int ci[8];
#pragma unroll
                for (int k = 0; k < 4; ++k) { float bvv = -__builtin_inff(); int bi = 64;
#pragma unroll
                    for (int i = 0; i < 16; ++i) { const int ei = crow(i, hh); const bool tk = lv[i] > bvv || (lv[i] == bvv && ei < bi); bvv = tk ? lv[i] : bvv; bi = tk ? ei : bi; }
#pragma unroll
                    for (int i = 0; i < 16; ++i) if (crow(i, hh) == bi) lv[i] = -__builtin_inff();
                    cv[k] = bvv; ci[k] = bi; }
#pragma unroll
                for (int k = 0; k < 4; ++k) { cv[4 + k] = __shfl_xor(cv[k], 32); ci[4 + k] = __shfl_xor(ci[k], 32); }
                float tv[4]; int te[4];
#pragma unroll
                for (int k = 0; k < 4; ++k) { float bvv = -__builtin_inff(); int bi = 64;
#pragma unroll
                    for (int i = 0; i < 8; ++i) { const bool tk = cv[i] > bvv || (cv[i] == bvv && ci[i] < bi); bvv = tk ? cv[i] : bvv; bi = tk ? ci[i] : bi; }
#pragma unroll
                    for (int i = 0; i < 8; ++i) if (ci[i] == bi) cv[i] = -__builtin_inff();
                    tv[k] = bvv; te[k] = bi; }
                const float e1 = __expf(tv[1] - tv[0]), e2 = __expf(tv[2] - tv[0]), e3 = __expf(tv[3] - tv[0]); const float inv = 1.0f / (1.0f + e1 + e2 + e3);
                if (hh == 0) { const float gk[4] = {inv, e1 * inv, e2 * inv, e3 * inv};
#pragma unroll
                    for (int k = 0; k < 4; ++k) { const int la = (w0 + r32) * 4 + k; a_g[la] = gk[k]; a_e[la] = te[k]; a_rank[la] = __hip_atomic_fetch_add(&lcnt[te[k]], 1, __ATOMIC_RELAXED, __HIP_MEMORY_SCOPE_WORKGROUP); } }
            }
            __syncthreads();
            if (tid < NE) lbase[tid] = (rep_ == 1) ? (int)__hip_atomic_fetch_add((unsigned*)(ctl + CW_CNT + layer * NE * 16 + tid * 16), (unsigned)lcnt[tid], RLX_AGENT) : 0;
            __syncthreads();
            if (rep_ == 1) for (int la = tid; la < chunk * 4; la += NTHR) { const int e = a_e[la]; const size_t ix = (size_t)e * ECAP + lbase[e] + a_rank[la]; const int pos = lbase[e] + a_rank[la];
                ((GAS int*)(ws + WS_RSLOT))[ix] = wbase * 4 + la; ((GAS int*)(ws + WS_ASG))[(size_t)wbase * 4 + la] = (e << 24) | pos; ((GAS float*)(ws + WS_AGATE))[(size_t)wbase * 4 + la] = a_g[la]; }
            __syncthreads();
            SEAM();
        }
        if (IN(sb + 11)) REPEAT(11) {
                OPQ();
            const int nM = moe_tables(A, layer, lds, tid);
            pg8::Gemm g{(const bf16*)(ws + WS_X8), (const bf16*)(ws + WS_W1) + (size_t)layer * NE * 2048 * 512, nM * 256, 2048, 512};
            pg8::MoeOrder S; S.init(nM * 256, 2048, G, bx, MOE_WGM); S.tile_e = lds + TAB_TILEE; S.tstart = (const LAS int*)(lds + TAB_TSTART); S.cnt = (const LAS int*)(lds + TAB_LCNT); S.cap = ECAP;
            pg8::EpiMoe1 E{ws + WS_ABUF, A.moe_b1 + (size_t)layer * NE * 2048};
            pg8::gemm_phase<pg8::EpiMoe1, pg8::MoeOrder, true, true, true>(lds + RING_OFF, g, S, E, wave_s, (const int*)(ws + WS_RSLOT), lds + GP_OFF); SEAM();
        }
        if (IN(sb + 12)) REPEAT(12) {
                OPQ();
            const int nM = moe_tables(A, layer, lds, tid);
            pg8::Gemm g{(const bf16*)(ws + WS_ABUF), (const bf16*)(ws + WS_W2) + (size_t)layer * NE * 1024 * 512, nM * 256, 1024, 512};
            pg8::MoeOrder S; S.init(nM * 256, 1024, G, bx, MOE_WGM); S.tile_e = lds + TAB_TILEE; S.tstart = (const LAS int*)(lds + TAB_TSTART); S.cnt = (const LAS int*)(lds + TAB_LCNT); S.cap = ECAP;
            S.rev = 1;
            if (rep_ == 0) S.pmmask = 31;
            pg8::EpiMoe2 E{(bf16*)(ws + WS_BIG), A.moe_b2 + (size_t)layer * NE * 1024};
            pg8::gemm_phase<pg8::EpiMoe2, pg8::MoeOrder, true, true, false, true>(lds + RING_OFF, g, S, E, wave_s, nullptr, lds + GP_OFF); SEAM();
        }
        if (IN(sb + 13)) REPEAT(13) {
                OPQ();
            const bf16* ybuf = (const bf16*)(ws + WS_BIG);
            moe_tables(A, layer, lds, tid); const LAS int* tstart = (const LAS int*)(lds + TAB_TSTART);
            f32x4 gv[4], bv[4];
#pragma unroll
            for (int jj = 0; jj < 4; ++jj) { gv[jj] = *(const f32x4*)(A.ln_g + (size_t)(layer * 2 + 1) * D + 4 * lane + 256 * jj); bv[jj] = *(const f32x4*)(A.ln_b + (size_t)(layer * 2 + 1) * D + 4 * lane + 256 * jj); }
            f32x4 ga[4], ba[4];
#pragma unroll
            for (int jj = 0; jj < 4; ++jj) { ga[jj] = *(const f32x4*)(A.ln_g + (size_t)(layer * 2 + 0) * D + 4 * lane + 256 * jj) * DN_ALPHA; ba[jj] = *(const f32x4*)(A.ln_b + (size_t)(layer * 2 + 0) * D + 4 * lane + 256 * jj) * DN_ALPHA; }
            constexpr int LSTEP = 0; (void)LSTEP; const int step = G * NWAVES, m0 = vcu * NWAVES + wave;
            unsigned long long tr[4], trn[4]; unsigned yr[4][4], yrn[4][4]; f32x2_t stc, stn; f32x4 agc, agq;
            v4u acq;
#define LN2_ISSUE(TR, YR, ST, mm, AC) do { const unsigned acs_[4] = {(AC).x, (AC).y, (AC).z, (AC).w}; \
                ST = *(const GAS f32x2_t*)(ws + WS_STATS + (size_t)(mm) * 8); \
                _Pragma("unroll") for (int jj = 0; jj < 4; ++jj) TR[jj] = *(const GAS unsigned long long*)(tbuf + (size_t)(mm) * D + 4 * lane + 256 * jj); \
                _Pragma("unroll") for (int k = 0; k < 4; ++k) { const size_t yrow_ = (size_t)(tstart[acs_[k] >> 24] * 256 + (int)(acs_[k] & 0xffffffu)) * D; \
                    _Pragma("unroll") for (int jj = 0; jj < 4; ++jj) YR[k][jj] = *(const GAS unsigned*)((const unsigned char*)ybuf + yrow_ + 4 * lane + 256 * jj); } } while (0)
            if (m0 < T) {
                { const v4u ac0 = *(const GAS v4u*)((const int*)(ws + WS_ASG) + (size_t)m0 * 4); agc = *(const GAS f32x4*)((const float*)(ws + WS_AGATE) + (size_t)m0 * 4);
                  const int m1 = m0 + step < T ? m0 + step : m0; acq = *(const GAS v4u*)((const int*)(ws + WS_ASG) + (size_t)m1 * 4); agq = *(const GAS f32x4*)((const float*)(ws + WS_AGATE) + (size_t)m1 * 4);
                  LN2_ISSUE(tr, yr, stc, m0, ac0); }
                for (int m = m0; m < T; m += step) {
                    const int mn = m + step < T ? m + step : m, mq = mn + step < T ? mn + step : mn;
                    const f32x4 agn = agq;
                    LN2_ISSUE(trn, yrn, stn, mn, acq);
                    acq = *(const GAS v4u*)((const int*)(ws + WS_ASG) + (size_t)mq * 4); agq = *(const GAS f32x4*)((const float*)(ws + WS_AGATE) + (size_t)mq * 4);
                    f32x4 v[4];
#pragma unroll
                    for (int jj = 0; jj < 4; ++jj) { const unsigned wl = (unsigned)tr[jj], wh = (unsigned)(tr[jj] >> 32); v[jj] = ((f32x4){bflo(wl), bfhi(wl), bflo(wh), bfhi(wh)} - stc.x) * stc.y * ga[jj] + ba[jj];
#pragma unroll
                        for (int k = 0; k < 4; ++k) { const unsigned w = yr[k][jj]; const float gk = agc[k];
                            const f32x2_t lo2 = __builtin_amdgcn_cvt_pk_f32_fp8(w, false), hi2 = __builtin_amdgcn_cvt_pk_f32_fp8(w, true);
                            v[jj].x += gk * lo2.x; v[jj].y += gk * lo2.y; v[jj].z += gk * hi2.x; v[jj].w += gk * hi2.y; } }
                    ln_row(v, gv, bv);
#pragma unroll
                    for (int jj = 0; jj < 4; ++jj) { if (layer + 1 == DEPTH && rep_ == 1) *(GAS f32x4*)(A.out + (size_t)m * D + 4 * lane + 256 * jj) = v[jj];
                        if (layer + 1 < DEPTH && rep_ == 1)
                        *(GAS unsigned long long*)(xb + (size_t)m * D + 4 * lane + 256 * jj) = (unsigned long long)cvtpk(v[jj].x, v[jj].y) | ((unsigned long long)cvtpk(v[jj].z, v[jj].w) << 32);
                        if constexpr (layer + 1 < N_A) *(GAS unsigned*)(ws + WS_X8 + (size_t)m * D + 4 * lane + 256 * jj) = __builtin_amdgcn_cvt_pk_fp8_f32(v[jj].z, v[jj].w, __builtin_amdgcn_cvt_pk_fp8_f32(v[jj].x, v[jj].y, 0u, false), true); }
#pragma unroll
                    for (int jj = 0; jj < 4; ++jj) { tr[jj] = trn[jj];
#pragma unroll
                        for (int k = 0; k < 4; ++k) yr[k][jj] = yrn[k][jj]; }
                    stc = stn; agc = agn;
                }
            }
#undef LN2_ISSUE
            if (layer + 1 < DEPTH) SEAM();
        }
}

__global__ void __launch_bounds__(NTHR, 2) yoco_fwd(Args A) {
    extern __shared__ __attribute__((aligned(16))) unsigned char lds_raw[];
    LAS unsigned char* lds = (LAS unsigned char*)lds_raw;
    volatile LAS unsigned* MISC = (volatile LAS unsigned*)(lds + MISC_OFF);
    const int wave_s = __builtin_amdgcn_readfirstlane((int)threadIdx.x >> 6); const int tid0 = tid_of(wave_s);
    const int G = gridDim.x; const int bx = blockIdx.x; const int vcu = (G % 8 == 0) ? (bx % 8) * (G / 8) + bx / 8 : bx;
    gu32* ctl0 = (gu32*)(A.ws + WS_CTL);
    for (int u = tid0; u < (LDS_BYTES - LDSCTL_OFF) / 4; u += NTHR) ((LAS unsigned*)(lds + LDSCTL_OFF))[u] = 0u;
    __syncthreads();
    XcdBarrier bar; bar.wave_s = wave_s; bar.bar = (unsigned*)(ctl0 + CW_BAR); bar.x = 0; bar.st = nullptr;
    if (A.single) bar = xcd_barrier_post((unsigned*)(ctl0 + CW_BAR), MISC + 8, wave_s);
    const int lo = A.st_lo, hi = A.st_hi;

    if (IN(0)) for (int rep_ = (REP_LAYER == 9) ? 0 : 1; rep_ < 2; ++rep_) { OPQ(); p0_prologue(A, lds, vcu, G, wave, lane, tid); SEAM(); }

    run_layer<0>(A, lds, bar, G, bx, vcu, lo, hi, wave_s);
    run_layer<1>(A, lds, bar, G, bx, vcu, lo, hi, wave_s);
    run_layer<2>(A, lds, bar, G, bx, vcu, lo, hi, wave_s);
    run_layer<3>(A, lds, bar, G, bx, vcu, lo, hi, wave_s);
#undef IN
#undef SEAM
}

extern "C" void kernel_launch(void* const* d_in, const int* in_sizes, int n_in, void* d_out, int out_size, void* d_ws, size_t ws_size, hipStream_t stream) {
    static int grid = 0;
    if (grid == 0) {
        if (n_in != 21 || in_sizes[0] != T * D || out_size != T * D || ws_size < WS_END) { fprintf(stderr, "kernel_launch: unexpected shapes (n_in %d, in0 %d, out %d, ws %zu)\n", n_in, n_in > 0 ? in_sizes[0] : -1, out_size, ws_size); grid = -1; return; }
        int dev = 0, cus = 0, per_cu = 0;
        if (hipGetDevice(&dev) != hipSuccess || hipDeviceGetAttribute(&cus, hipDeviceAttributeMultiprocessorCount, dev) != hipSuccess) { grid = -1; return; }
        if (hipFuncSetAttribute((const void*)yoco_fwd, hipFuncAttributeMaxDynamicSharedMemorySize, LDS_BYTES) != hipSuccess) { fprintf(stderr, "kernel_launch: hipFuncSetAttribute failed\n"); grid = -1; return; }
        if (hipOccupancyMaxActiveBlocksPerMultiprocessor(&per_cu, (const void*)yoco_fwd, NTHR, LDS_BYTES) != hipSuccess || per_cu < 1) fprintf(stderr, "kernel_launch: occupancy query reports %d\n", per_cu);
        (void)hipGetLastError();
        grid = cus;
        if (grid != 256) { fprintf(stderr, "kernel_launch: built for 256 CUs, device has %d\n", cus); grid = -1; return; }
    }
    if (grid < 0) return;
    if (hipMemsetAsync((char*)d_ws + WS_CTL, 0, CTL_ZERO_BYTES, stream) != hipSuccess) return;
    Args a{};
    a.x = (const float*)d_in[0]; a.pos = (const int*)d_in[1]; a.ln_g = (const float*)d_in[2]; a.ln_b = (const float*)d_in[3]; a.hg_w_in = (const float*)d_in[4]; a.hg_lb = (const float*)d_in[5];
    a.hg_gnorm = (const float*)d_in[6]; a.hg_w_o = (const float*)d_in[7]; a.mla_w_dq = (const float*)d_in[8]; a.mla_q_norm = (const float*)d_in[9]; a.mla_w_uq = (const float*)d_in[10]; a.mla_w_o = (const float*)d_in[11];
    a.kv_w_a = (const float*)d_in[12]; a.kv_norm = (const float*)d_in[13]; a.kv_w_b = (const float*)d_in[14]; a.router_w = (const float*)d_in[15]; a.router_b = (const float*)d_in[16];
    a.moe_w1 = (const float*)d_in[17]; a.moe_b1 = (const float*)d_in[18]; a.moe_w2 = (const float*)d_in[19]; a.moe_b2 = (const float*)d_in[20];
    a.out = (float*)d_out; a.ws = (unsigned char*)d_ws; a.pad = 0;
#if MK_SINGLE
    a.st_lo = 0; a.st_hi = 1 << 20; a.single = 1;
    hipLaunchKernelGGL(yoco_fwd, dim3(grid), dim3(NTHR), LDS_BYTES, stream, a);
#else
    a.single = 0;
    for (int st = 0; st < 1 + DEPTH * 16; ++st) {
        if (st > 0) { const int layer = (st - 1) / 16, loc = (st - 1) % 16; if (loc > 13 || loc == 10) continue;
            if (layer < N_A) { if (loc >= 2 && loc <= 7) continue; }
            else { if (loc == 2 || loc == 3 || (layer != N_A && loc <= 1)) continue; } }
        a.st_lo = st; a.st_hi = st + 1;
        hipLaunchKernelGGL(yoco_fwd, dim3(grid), dim3(NTHR), LDS_BYTES, stream, a);
    }
#endif
}
```

```cpp
#include <hip/hip_runtime.h>
#include <cstdio>
#include <cstdint>
#ifndef MK_SINGLE
#define MK_SINGLE 1
#endif
#ifndef MOE_WGM
#define MOE_WGM 8
#endif
#ifndef REP_MASK
#define REP_MASK 0
#define REP_LAYER 0
#endif
__device__ __forceinline__ int tid_of(int wave_s) { int l; asm volatile("v_mbcnt_lo_u32_b32 %0, -1, 0\n\tv_mbcnt_hi_u32_b32 %0, -1, %0" : "=v"(l)); return wave_s * 64 + l; }
namespace pg8 {

#define PG8_LAS __attribute__((address_space(3)))
typedef unsigned short bf16_t;
typedef short bf16x8 __attribute__((ext_vector_type(8)));
typedef float f32x4 __attribute__((ext_vector_type(4)));
typedef unsigned u32x4 __attribute__((ext_vector_type(4)));
constexpr float W1_SC = 128.0f, W2_SC = 256.0f, H_SC = 4.0f, HIN_SC = 128.0f, MWO_SC = 256.0f, OB_SC = 16.0f, Q_SC = 64.0f, K_SC = 16.0f, HWO_SC = 256.0f, OG_SC = 4.0f;
typedef int i32x4 __attribute__((ext_vector_type(4))); typedef int i32x8 __attribute__((ext_vector_type(8)));
constexpr int BM = 256, BK = 64, HALF = 128, HTB = HALF * BK * 2  , STAGE_BYTES = 8 * HTB, NXCD = 8, WGM = 8;

__host__ __device__ __forceinline__ int lds_byte(int r, int c) { const int st = (r >> 4) * 2 + (c >> 5), rr = r & 15, cc = c & 31, ob = rr * 64 + cc * 2; return st * 1024 + (ob ^ (((ob >> 9) & 1) << 5)); }
__host__ __device__ __forceinline__ void stage_rc(int b, int& R, int& C) { const int st = b / 1024, sb = b % 1024, swz = sb ^ (((sb >> 9) & 1) << 5); R = (st >> 1) * 16 + swz / 64; C = (st & 1) * 32 + (swz % 64) / 2; }
__host__ __device__ __forceinline__ int perm32(int rho) { const int n = rho >> 4, i = rho & 15; return 8 * (i >> 2) + 4 * n + (i & 3); }

#ifndef KROT
#define KROT 0
#endif
struct Unit { int pm, pn, pb, e, g0, gc, kr; };
struct Gemm { const bf16_t* A; const bf16_t* Bt; int M, N, K; };

struct StaticOrder {
    int rev = 0; int nM, nN, nwg, G, c, wgm;
    __host__ __device__ void init(int M, int N, int G_, int c_, int wgm_ = WGM) { nM = M / BM; nN = N / BM; nwg = nM * nN; G = G_; c = c_; wgm = wgm_; }
    __host__ __device__ bool next(int i, Unit& u) const {
        const long L = (long)i * G + c; if (L >= nwg) return false;
        int wgid = (int)L; { const int q = nwg / NXCD, r = nwg % NXCD, xcd = wgid % NXCD; int off = wgid / NXCD; if (rev) off = (xcd < r ? q : q - 1) - off;     wgid = (xcd < r ? xcd * (q + 1) : r * (q + 1) + (xcd - r) * q) + off; }
        const int nig = wgm * nN, gid = wgid / nig, rem = wgid - gid * nig, fm = gid * wgm, gsz = (nM - fm) < wgm ? (nM - fm) : wgm;
        if (gsz == 8) { u.pm = fm + (rem & 7); u.pn = rem >> 3; } else { u.pm = fm + (rem % gsz); u.pn = rem / gsz; }
        u.pb = u.pn; u.e = 0; u.g0 = 0; u.gc = 0; u.kr = KROT ? ((u.pm + u.pn) & 3) : 0; return true;
    }
    __device__ __forceinline__ void a_ready(const Unit&) const {}
    __device__ __forceinline__ void done(const Unit&) const {}
};


__device__ __forceinline__ unsigned cvt_pk_bf16(float lo, float hi) { unsigned r; asm volatile("v_cvt_pk_bf16_f32 %0, %1, %2" : "=v"(r) : "v"(lo), "v"(hi)); return r; }
typedef unsigned u32x2 __attribute__((ext_vector_type(2)));
#define PG8_GAS __attribute__((address_space(1)))
__device__ __forceinline__ float sigmoidf_(float v) { return __builtin_amdgcn_rcpf(1.0f + __expf(-v)); }
__device__ __forceinline__ float siluf_(float v) { return v * sigmoidf_(v); }
__device__ __forceinline__ u32x4 pack8(const f32x4 v0, const f32x4 v1) { u32x4 w; w.x = cvt_pk_bf16(v0[0], v0[1]); w.y = cvt_pk_bf16(v0[2], v0[3]); w.z = cvt_pk_bf16(v1[0], v1[1]); w.w = cvt_pk_bf16(v1[2], v1[3]); return w; }

struct EpiPlain {
    static constexpr bool PERM = true, AFTER_DRAIN = false, PROBE_TWICE = false, LDS_PARAMS = false, PERM2 = false, FP8 = false, KT1 = true, SWAP12 = false;
    bf16_t* O; int ldc; float sc;
    __device__ __forceinline__ void operator()(const f32x4 (&acc)[2][2][4][2], const Unit& u, int wr, int wc, int fr, int fq) const {
        const int row0 = u.pm * BM + wr * 64 + fr, col0 = u.pn * BM + wc * 32 + 8 * fq;
#pragma unroll
        for (int ai = 0; ai < 2; ++ai)
#pragma unroll
            for (int m = 0; m < 4; ++m) { bf16_t* rowp = O + (size_t)(row0 + ai * HALF + m * 16) * ldc + col0;
#pragma unroll
                for (int bj = 0; bj < 2; ++bj) *(PG8_GAS u32x4*)(rowp + bj * HALF) = pack8(acc[ai][bj][m][0] * sc, acc[ai][bj][m][1] * sc); }
    }
};
struct EpiHgIn {
    static constexpr bool PERM = true, AFTER_DRAIN = false, PROBE_TWICE = false, LDS_PARAMS = false, PERM2 = false, FP8 = true, KT1 = true, SWAP12 = false;
    bf16_t* O; const float* lb;
    __device__ __forceinline__ void operator()(const f32x4 (&acc)[2][2][4][2], const Unit& u, int wr, int wc, int fr, int fq) const {
        const int row0 = u.pm * BM + wr * 64 + fr, col0 = u.pn * BM + wc * 32 + 8 * fq, kind = u.pn >> 2, ch0 = (u.pn & 3) * BM + wc * 32 + 8 * fq;
        f32x4 lbv[2][2];
#pragma unroll
        for (int bj = 0; bj < 2; ++bj)
#pragma unroll
            for (int n = 0; n < 2; ++n) lbv[bj][n] = (kind == 1) ? *(const PG8_GAS f32x4*)(lb + ch0 + bj * HALF + 4 * n) : (f32x4){0.f, 0.f, 0.f, 0.f};
#pragma unroll
        for (int ai = 0; ai < 2; ++ai)
#pragma unroll
            for (int m = 0; m < 4; ++m) { bf16_t* rowp = O + ((size_t)((u.pm * 16 + ai * 8 + wr * 4 + m) * 128 + u.pn * 8 + wc) * 512 + fr * 32 + 8 * fq);
#pragma unroll
                for (int bj = 0; bj < 2; ++bj) { f32x4 v[2] = {acc[ai][bj][m][0] * (1.0f / HIN_SC), acc[ai][bj][m][1] * (1.0f / HIN_SC)};
                    if (kind == 0 || kind == 3) {
#pragma unroll
                        for (int n = 0; n < 2; ++n)
#pragma unroll
                            for (int j = 0; j < 4; ++j) v[n][j] = siluf_(v[n][j]);
                    } else if (kind == 1) {
#pragma unroll
                        for (int n = 0; n < 2; ++n)
#pragma unroll
                            for (int j = 0; j < 4; ++j) { const float l = lbv[bj][n][j]; v[n][j] = __log2f(l + (1.0f - l) * sigmoidf_(v[n][j])); }
                    }
                    *(PG8_GAS u32x4*)(rowp + bj * 4 * 512) = pack8(v[0], v[1]); } }
    }
};
template <bool F8> struct EpiResT {
    static constexpr bool PERM = true, AFTER_DRAIN = false, PROBE_TWICE = false, LDS_PARAMS = false, PERM2 = false, FP8 = F8, KT1 = true, SWAP12 = false;
    const bf16_t* res; bf16_t* out; float alpha, sc;
    __device__ __forceinline__ void operator()(const f32x4 (&acc)[2][2][4][2], const Unit& u, int wr, int wc, int fr, int fq) const {
        const int row0 = u.pm * BM + wr * 64 + fr, col0 = u.pn * BM + wc * 32 + 8 * fq;
        u32x4 rv[2][4][2];
#pragma unroll
        for (int ai = 0; ai < 2; ++ai)
#pragma unroll
            for (int m = 0; m < 4; ++m)
#pragma unroll
                for (int bj = 0; bj < 2; ++bj) rv[ai][m][bj] = *(const PG8_GAS u32x4*)(res + (size_t)(row0 + ai * HALF + m * 16) * 1024 + col0 + bj * HALF);
#pragma unroll
        for (int ai = 0; ai < 2; ++ai)
#pragma unroll
            for (int m = 0; m < 4; ++m) { const size_t off = (size_t)(row0 + ai * HALF + m * 16) * 1024 + col0;
#pragma unroll
                for (int bj = 0; bj < 2; ++bj) { const u32x4 r = rv[ai][m][bj];
                    const f32x4 r0 = {__builtin_bit_cast(float, r.x << 16), __builtin_bit_cast(float, r.x & 0xffff0000u), __builtin_bit_cast(float, r.y << 16), __builtin_bit_cast(float, r.y & 0xffff0000u)};
                    const f32x4 r1 = {__builtin_bit_cast(float, r.z << 16), __builtin_bit_cast(float, r.z & 0xffff0000u), __builtin_bit_cast(float, r.w << 16), __builtin_bit_cast(float, r.w & 0xffff0000u)};
                    if constexpr (F8) *(PG8_GAS u32x4*)(out + off + bj * HALF) = pack8(r0 * alpha + acc[ai][bj][m][0] * sc, r1 * alpha + acc[ai][bj][m][1] * sc);
                    else *(PG8_GAS u32x4*)(out + off + bj * HALF) = pack8(r0 * alpha + acc[ai][bj][m][0], r1 * alpha + acc[ai][bj][m][1]); } }
    }
};
__device__ __forceinline__ void rope8(f32x4& v0, f32x4& v1, const float* cs) {
    const f32x4 c0 = *(const PG8_GAS f32x4*)cs, c1 = *(const PG8_GAS f32x4*)(cs + 4);
    const float a0 = v0[0], b0 = v0[1], a1 = v0[2], b1 = v0[3], a2 = v1[0], b2 = v1[1], a3 = v1[2], b3 = v1[3];
    v0[0] = a0 * c0[0] - b0 * c0[1]; v0[1] = a0 * c0[1] + b0 * c0[0]; v0[2] = a1 * c0[2] - b1 * c0[3]; v0[3] = a1 * c0[3] + b1 * c0[2];
    v1[0] = a2 * c1[0] - b2 * c1[1]; v1[1] = a2 * c1[1] + b2 * c1[0]; v1[2] = a3 * c1[2] - b3 * c1[3]; v1[3] = a3 * c1[3] + b3 * c1[2];
}
struct EpiKva {
    static constexpr bool PERM = true, AFTER_DRAIN = false, PROBE_TWICE = false, LDS_PARAMS = false, PERM2 = false, FP8 = false, KT1 = true, SWAP12 = false;
    bf16_t* O; const float* rope;
    __device__ __forceinline__ void operator()(const f32x4 (&acc)[2][2][4][2], const Unit& u, int wr, int wc, int fr, int fq) const {
        const int row0 = u.pm * BM + wr * 64 + fr, col0 = wc * 32 + 8 * fq;
#pragma unroll
        for (int ai = 0; ai < 2; ++ai)
#pragma unroll
            for (int m = 0; m < 4; ++m) { const int row = row0 + ai * HALF + m * 16; bf16_t* rowp = O + (size_t)row * 256 + col0;
                *(PG8_GAS u32x4*)(rowp) = pack8(acc[ai][0][m][0], acc[ai][0][m][1]);
                f32x4 v0 = acc[ai][1][m][0], v1 = acc[ai][1][m][1];
                if (wc < 2) rope8(v0, v1, rope + (size_t)row * 64 + (wc * 16 + 4 * fq) * 2);
                else { v0 = (f32x4){0.f, 0.f, 0.f, 0.f}; v1 = v0; }
                *(PG8_GAS u32x4*)(rowp + HALF) = pack8(v0, v1); }
    }
};
struct EpiUq {
    static constexpr bool PERM = true, AFTER_DRAIN = false, PROBE_TWICE = false, LDS_PARAMS = false, PERM2 = false, FP8 = false, KT1 = true, SWAP12 = false;
    bf16_t* O; const float* rope; float sc;
    __device__ __forceinline__ void operator()(const f32x4 (&acc)[2][2][4][2], const Unit& u, int wr, int wc, int fr, int fq) const {
        const int row0 = u.pm * BM + wr * 64 + fr, col0 = u.pn * BM + wc * 32 + 8 * fq;
        const PG8_GAS float* __restrict__ rp = (const PG8_GAS float*)rope; PG8_GAS bf16_t* __restrict__ op = (PG8_GAS bf16_t*)O;
#pragma unroll
        for (int ai = 0; ai < 2; ++ai)
#pragma unroll
            for (int m = 0; m < 4; ++m) { const int row = row0 + ai * HALF + m * 16; PG8_GAS unsigned char* rowp = (PG8_GAS unsigned char*)op + ((size_t)((u.pm * 16 + ai * 8 + wr * 4 + m) * 96 + u.pn * 8 + wc) * 512 + fr * 32 + 8 * fq);
#pragma unroll
                for (int bj = 0; bj < 2; ++bj) { const int r = __builtin_amdgcn_readfirstlane((u.pn * BM + wc * 32 + bj * HALF) % 192) + 8 * fq; f32x4 v0 = acc[ai][bj][m][0] * sc, v1 = acc[ai][bj][m][1] * sc;
                    if (r >= 128) { const PG8_GAS float* cs = rp + (size_t)row * 64 + (r - 128); const f32x4 c0 = *(const PG8_GAS f32x4*)cs, c1 = *(const PG8_GAS f32x4*)(cs + 4);
                        const float a0 = v0[0], b0 = v0[1], a1 = v0[2], b1 = v0[3], a2 = v1[0], b2 = v1[1], a3 = v1[2], b3 = v1[3];
                        v0[0] = a0 * c0[0] - b0 * c0[1]; v0[1] = a0 * c0[1] + b0 * c0[0]; v0[2] = a1 * c0[2] - b1 * c0[3]; v0[3] = a1 * c0[3] + b1 * c0[2];
                        v1[0] = a2 * c1[0] - b2 * c1[1]; v1[1] = a2 * c1[1] + b2 * c1[0]; v1[2] = a3 * c1[2] - b3 * c1[3]; v1[3] = a3 * c1[3] + b3 * c1[2]; }
                    u32x2 w8; w8.x = __builtin_amdgcn_cvt_pk_fp8_f32(v0[0] * Q_SC, v0[1] * Q_SC, 0u, false); w8.x = __builtin_amdgcn_cvt_pk_fp8_f32(v0[2] * Q_SC, v0[3] * Q_SC, w8.x, true);
                    w8.y = __builtin_amdgcn_cvt_pk_fp8_f32(v1[0] * Q_SC, v1[1] * Q_SC, 0u, false); w8.y = __builtin_amdgcn_cvt_pk_fp8_f32(v1[2] * Q_SC, v1[3] * Q_SC, w8.y, true);
                    *(PG8_GAS u32x2*)(rowp + bj * 4 * 512) = w8; } }
    }
};
struct EpiMoe1 {
    static constexpr bool PERM = true, AFTER_DRAIN = false, PROBE_TWICE = false, LDS_PARAMS = true, PERM2 = true, FP8 = true, KT1 = true, SWAP12 = true;
    unsigned char* O; const float* b1;
    __device__ __forceinline__ void prefetch(const Unit& u, PG8_LAS unsigned char* slot, int lane) const { __builtin_amdgcn_global_load_lds((const unsigned*)(b1 + (size_t)u.e * 2048 + u.pn * BM + lane * 4), (PG8_LAS unsigned*)slot, 16, 0, 0); }
    __device__ __forceinline__ void operator()(const f32x4 (&acc)[2][2][4][2], const Unit& u, int wr, int wc, int fr, int fq, const PG8_LAS unsigned char* ps) const {
        const PG8_LAS float* bp = (const PG8_LAS float*)ps + wc * 64 + 16 * fq;
        f32x4 bv[2][2];
#pragma unroll
        for (int bj = 0; bj < 2; ++bj)
#pragma unroll
            for (int n = 0; n < 2; ++n) { const f32x4 b_ = *(const PG8_LAS f32x4*)(bp + bj * 8 + 4 * n); bv[bj][n] = __builtin_shufflevector(b_, b_, 0, 2, 1, 3); }
        typedef float f32x2 __attribute__((ext_vector_type(2)));
#pragma unroll
        for (int ai = 0; ai < 2; ++ai)
#pragma unroll
            for (int m = 0; m < 4; ++m) { unsigned char* rowp = O + ((size_t)((u.pm * 16 + wr * 4 + ai * 8 + m) * 32 + u.pn * 4 + wc) * 512 + fr * 32 + 8 * fq);
                u32x2 w;
#pragma unroll
                for (int bj = 0; bj < 2; ++bj) { unsigned wq = 0u;
#pragma unroll
                    for (int n = 0; n < 2; ++n) { const f32x4 v = acc[ai][bj][m][n] * (1.0f / W1_SC) + bv[bj][n];
                        const f32x2 g = {v[0], v[1]}, l = {v[2], v[3]};
                        const f32x2 xg = {fminf(g.x, 7.0f), fminf(g.y, 7.0f)}, xl = {fminf(fmaxf(l.x, -7.0f), 7.0f), fminf(fmaxf(l.y, -7.0f), 7.0f)};
                        const f32x2 tt = xg * -2.4554669595930156f;
                        const f32x2 d = (f32x2){__builtin_amdgcn_exp2f(tt.x), __builtin_amdgcn_exp2f(tt.y)} + 1.0f;
                        const f32x2 r = {__builtin_amdgcn_rcpf(d.x), __builtin_amdgcn_rcpf(d.y)};
                        const f32x2 o = (xg * (xl * H_SC + H_SC)) * r;
                        wq = (n == 0) ? __builtin_amdgcn_cvt_pk_fp8_f32(o.x, o.y, wq, false) : __builtin_amdgcn_cvt_pk_fp8_f32(o.x, o.y, wq, true); }
                    if (bj == 0) w.x = wq; else w.y = wq; }
                *(PG8_GAS u32x2*)rowp = w; }
    }
};
struct EpiMoe2 {
    static constexpr bool PERM = true, AFTER_DRAIN = false, PROBE_TWICE = false, LDS_PARAMS = true, PERM2 = true, FP8 = true, KT1 = true, SWAP12 = false;
    bf16_t* O; const float* b2;
    __device__ __forceinline__ void prefetch(const Unit& u, PG8_LAS unsigned char* slot, int lane) const { __builtin_amdgcn_global_load_lds((const unsigned*)(b2 + (size_t)u.e * 1024 + u.pn * BM + lane * 4), (PG8_LAS unsigned*)slot, 16, 0, 0); }
    __device__ __forceinline__ void operator()(const f32x4 (&acc)[2][2][4][2], const Unit& u, int wr, int wc, int fr, int fq, const PG8_LAS unsigned char* ps) const {
        const int row0 = u.pm * BM + wr * 64 + fr, cl = wc * 64 + 16 * fq, col0 = u.pn * BM + cl;
        const PG8_LAS float* bp = (const PG8_LAS float*)ps + cl;
        f32x4 bv[2][2];
#pragma unroll
        for (int bj = 0; bj < 2; ++bj)
#pragma unroll
            for (int n = 0; n < 2; ++n) bv[bj][n] = *(const PG8_LAS f32x4*)(bp + bj * 8 + 4 * n);
#pragma unroll
        for (int ai = 0; ai < 2; ++ai)
#pragma unroll
            for (int m = 0; m < 4; ++m) { unsigned char* rowp = (unsigned char*)O + (size_t)(row0 + ai * HALF + m * 16) * 1024 + col0;
                u32x4 w; unsigned wq[4];
#pragma unroll
                for (int bj = 0; bj < 2; ++bj) { const f32x4 v0 = acc[ai][bj][m][0] * (1.0f / (W2_SC * H_SC)) + bv[bj][0], v1 = acc[ai][bj][m][1] * (1.0f / (W2_SC * H_SC)) + bv[bj][1];
                    wq[2 * bj] = __builtin_amdgcn_cvt_pk_fp8_f32(v0[0], v0[1], 0u, false); wq[2 * bj] = __builtin_amdgcn_cvt_pk_fp8_f32(v0[2], v0[3], wq[2 * bj], true);
                    wq[2 * bj + 1] = __builtin_amdgcn_cvt_pk_fp8_f32(v1[0], v1[1], 0u, false); wq[2 * bj + 1] = __builtin_amdgcn_cvt_pk_fp8_f32(v1[2], v1[3], wq[2 * bj + 1], true); }
                w.x = wq[0]; w.y = wq[1]; w.z = wq[2]; w.w = wq[3];
                *(PG8_GAS u32x4*)rowp = w; }
    }
};
struct MoeOrder : StaticOrder {
    int pmmask = -1;
    const PG8_LAS unsigned char* tile_e; const PG8_LAS int* tstart; const PG8_LAS int* cnt; int cap;
    __device__ __forceinline__ bool next(int i, Unit& u) const {
        if (!StaticOrder::next(i, u)) return false;
        u.e = __builtin_amdgcn_readfirstlane((int)tile_e[u.pm]); u.pb = u.e * nN + u.pn; u.kr = KROT ? ((u.e + u.pn) & 3) : 0;
        const int ti = u.pm - __builtin_amdgcn_readfirstlane(tstart[u.e]); u.g0 = u.e * cap + ti * BM; u.gc = __builtin_amdgcn_readfirstlane(cnt[u.e]) - ti * BM; u.pm &= pmmask; return true;
    }
};

template <class Epi, class Sched, bool ALIGN_EPI = false, bool SP2 = false, bool GATHER = false, bool ATILED = false>
__device__ __forceinline__ void gemm_phase(PG8_LAS unsigned char* lds, const Gemm g, const Sched& S, const Epi& E, const int wave_s, const int* gtab = nullptr, PG8_LAS unsigned char* par = nullptr) {
    static_assert((!GATHER && !ATILED && !Epi::PERM2) || SP2, "gather / tiled A are wired into the SP2 loop only"); static_assert(!(GATHER && ATILED), "one or the other");
    int tid_ = tid_of(wave_s); asm volatile("" : "+v"(tid_));
    const int tid = tid_, wid = __builtin_amdgcn_readfirstlane(tid >> 6), lane = tid & 63, wr = wid >> 2, wc = wid & 3, fr = lane & 15, fq = lane >> 4;
    const int K = g.K, nt = K / BK;
    unsigned voffA[2], voffB[2];
#pragma unroll
    for (int i = 0; i < 2; ++i) { int R, C; stage_rc(tid * 16 + i * 8192, R, C); const int Rb = Epi::PERM2 ? (64 * (R >> 5) + 16 * ((R & 15) >> 2) + 4 * ((R >> 4) & 1) + (Epi::SWAP12 ? (((R & 1) << 1) | ((R >> 1) & 1)) : (R & 3)))        : Epi::PERM ? ((R & ~31) + perm32(R & 31)) : R;
        voffA[i] = ATILED ? (unsigned)(((R >> 4) * (K >> 4) + (C >> 4)) * 256 + (R & 15) * 16 + (C & 15)) * 2u : (unsigned)(R * K + C) * 2u; voffB[i] = (unsigned)(((Rb >> 4) * (K >> 5) + (C >> 5)) * 512 + (Rb & 15) * 32 + (C & 31)) * 2u; }
    unsigned offC[2][2];
#define PG8_GOFF(dst, u) do { _Pragma("unroll") for (int h_ = 0; h_ < 2; ++h_) _Pragma("unroll") for (int i_ = 0; i_ < 2; ++i_) { int R_, C_; stage_rc(tid * 16 + i_ * 8192, R_, C_); const int rr_ = h_ * HALF + R_; \
        const int a_ = (rr_ < (u).gc) ? *(const PG8_GAS int*)(gtab + (u).g0 + rr_) : 0; dst[h_][i_] = (unsigned)((a_ >> 2) * K + C_) * 2u; } } while (0)

    const size_t kstep = (size_t)(BK * 2);
    const size_t kstepA = ATILED ? (size_t)(BK / 16) * 512 : kstep;
    const size_t kstepB = (size_t)(BK / 32) * 1024;
    const size_t hstep = (size_t)HALF * K * 2;
    const size_t tstep = 2 * hstep;
    const size_t hstepB = Epi::PERM2 ? (size_t)(8 * 32 * 2) : hstep;
    const unsigned ldsw = (unsigned)wid * 1024u;
    const int aoff = lds_byte(wr * 64 + fr, fq * 8), boff = lds_byte(wc * 32 + fr, fq * 8);
#define PG8_SA(b, h) (((b) * 2 + (h)) * HTB)
#define PG8_SB(b, h) ((4 + (b) * 2 + (h)) * HTB)
#define PG8_STAGE(bufoff, gbase, voff) do { _Pragma("unroll") for (int _i = 0; _i < 2; ++_i) \
        __builtin_amdgcn_global_load_lds((const unsigned*)((const char*)(gbase) + (voff)[_i]), (PG8_LAS unsigned*)(lds + (bufoff) + ldsw + _i * 8192), 16, 0, 0); } while (0)
#define PG8_STAGE_A(bufoff, kptr, h) do { if constexpr (GATHER) { PG8_STAGE(bufoff, kptr, offC[h]); } else { PG8_STAGE(bufoff, (kptr) + ((h) ? hstep : 0), voffA); } } while (0)
#define PG8_CAT(x0, x1) __builtin_shufflevector(x0, x1, 0, 1, 2, 3, 4, 5, 6, 7)
#define PG8_LDA(dst, b, h) do { _Pragma("unroll") for (int m = 0; m < 4; ++m) { if constexpr (Epi::FP8) dst##8[m] = PG8_CAT(*(const PG8_LAS i32x4*)(lds + PG8_SA(b, h) + aoff + m * 2048), *(const PG8_LAS i32x4*)(lds + PG8_SA(b, h) + aoff + m * 2048 + 1024)); \
        else { _Pragma("unroll") for (int k = 0; k < 2; ++k) dst[m][k] = *(const PG8_LAS bf16x8*)(lds + PG8_SA(b, h) + aoff + m * 2048 + k * 1024); } } } while (0)
#define PG8_LDB(dst, b, h) do { _Pragma("unroll") for (int n = 0; n < 2; ++n) { if constexpr (Epi::FP8) dst##8[n] = PG8_CAT(*(const PG8_LAS i32x4*)(lds + PG8_SB(b, h) + boff + n * 2048), *(const PG8_LAS i32x4*)(lds + PG8_SB(b, h) + boff + n * 2048 + 1024)); \
        else { _Pragma("unroll") for (int k = 0; k < 2; ++k) dst[n][k] = *(const PG8_LAS bf16x8*)(lds + PG8_SB(b, h) + boff + n * 2048 + k * 1024); } } } while (0)
#define PG8_MMA(ai, bj, At, Bt) do { __builtin_amdgcn_s_setprio(1); if constexpr (Epi::FP8) { _Pragma("unroll") for (int m = 0; m < 4; ++m) _Pragma("unroll") for (int n = 0; n < 2; ++n) \
        acc[ai][bj][m][n] = __builtin_amdgcn_mfma_scale_f32_16x16x128_f8f6f4(Bt##8[n], At##8[m], acc[ai][bj][m][n], 0, 0, 0, 0, 0, 0); } else { \
        _Pragma("unroll") for (int m = 0; m < 4; ++m) _Pragma("unroll") for (int n = 0; n < 2; ++n) _Pragma("unroll") for (int k = 0; k < 2; ++k) \
        acc[ai][bj][m][n] = __builtin_amdgcn_mfma_f32_16x16x32_bf16(Bt[n][k], At[m][k], acc[ai][bj][m][n], 0, 0, 0); } __builtin_amdgcn_s_setprio(0); } while (0)
#define PG8_MMAZ(ai, bj, At, Bt) do { __builtin_amdgcn_s_setprio(1); if constexpr (Epi::FP8) { _Pragma("unroll") for (int m = 0; m < 4; ++m) _Pragma("unroll") for (int n = 0; n < 2; ++n) \
        acc[ai][bj][m][n] = __builtin_amdgcn_mfma_scale_f32_16x16x128_f8f6f4(Bt##8[n], At##8[m], (f32x4){0.f, 0.f, 0.f, 0.f}, 0, 0, 0, 0, 0, 0); } else { \
        _Pragma("unroll") for (int m = 0; m < 4; ++m) _Pragma("unroll") for (int n = 0; n < 2; ++n) { acc[ai][bj][m][n] = __builtin_amdgcn_mfma_f32_16x16x32_bf16(Bt[n][0], At[m][0], (f32x4){0.f, 0.f, 0.f, 0.f}, 0, 0, 0); \
            acc[ai][bj][m][n] = __builtin_amdgcn_mfma_f32_16x16x32_bf16(Bt[n][1], At[m][1], acc[ai][bj][m][n], 0, 0, 0); } } __builtin_amdgcn_s_setprio(0); } while (0)
#define PG8_WAIT_V(n) asm volatile("s_waitcnt vmcnt(" #n ")" ::: "memory")
#define PG8_WAIT_L(n) asm volatile("s_waitcnt lgkmcnt(" #n ")" ::: "memory")
#define PG8_BAR __builtin_amdgcn_s_barrier()
#define PG8_SCHED __builtin_amdgcn_sched_barrier(0)
    Unit cur, nxt; int ui = 0;
    if (!S.next(0, cur)) return;
    f32x4 acc[2][2][4][2];
    if constexpr (!Epi::KT1) {
#pragma unroll
    for (int a = 0; a < 2; ++a)
#pragma unroll
        for (int b = 0; b < 2; ++b)
#pragma unroll
            for (int m = 0; m < 4; ++m)
#pragma unroll
                for (int n = 0; n < 2; ++n) acc[a][b][m][n] = (f32x4){0.f, 0.f, 0.f, 0.f};
    }
    bf16x8 At[4][2], B0[2][2], B1[2][2]; i32x8 At8[4], B08[2], B18[2]; (void)At; (void)B0; (void)B1; (void)At8; (void)B08; (void)B18;
    const char* cA = (const char*)g.A + (GATHER ? (size_t)0 : (size_t)cur.pm * tstep); const char* cB = (const char*)g.Bt + (size_t)cur.pb * tstep;
    if constexpr (GATHER) PG8_GOFF(offC, cur);
    const int ntm = nt - 1, ntq = nt >> 2; int ck = (cur.kr * ntq) & ~1;
    cA += (size_t)ck * kstepA; cB += (size_t)ck * kstepB;
    S.a_ready(cur);
    if constexpr (SP2) {
        PG8_STAGE(PG8_SB(0, 0), cB, voffB); PG8_STAGE(PG8_SB(0, 1), cB + hstepB, voffB); PG8_STAGE_A(PG8_SA(0, 0), cA, 0); PG8_STAGE_A(PG8_SA(0, 1), cA, 1);
        if (wr == 1) PG8_BAR;
        PG8_WAIT_V(2); PG8_BAR;
        PG8_STAGE(PG8_SB(1, 0), cB + kstepB, voffB); PG8_STAGE_A(PG8_SA(1, 0), cA + kstepA, 0); PG8_STAGE(PG8_SB(1, 1), cB + hstepB + kstepB, voffB);
        PG8_WAIT_V(6); PG8_BAR;
    } else {
        PG8_STAGE(PG8_SB(0, 0), cB, voffB); PG8_STAGE(PG8_SA(0, 0), cA, voffA); PG8_STAGE(PG8_SB(0, 1), cB + hstep, voffB); PG8_STAGE(PG8_SA(0, 1), cA + hstep, voffA);
        if (wr == 1) PG8_BAR;
        PG8_WAIT_V(4); PG8_BAR;
        PG8_STAGE(PG8_SB(1, 0), cB + kstepB, voffB); PG8_STAGE(PG8_SA(1, 0), cA + kstep, voffA); PG8_STAGE(PG8_SB(1, 1), cB + hstep + kstepB, voffB);
        PG8_WAIT_V(6); PG8_BAR;
    }
    for (;;) {
        const bool has_next = S.next(ui + 1, nxt);
        if constexpr (GATHER) { if (has_next && wid < 4) __builtin_amdgcn_global_load_lds((const unsigned*)(gtab + nxt.g0 + 64 * wid + lane), (PG8_LAS unsigned*)(par + 2048 + wid * 256), 4, 0, 0); }
        if constexpr (Epi::LDS_PARAMS) { if (wid == 0) E.prefetch(cur, par + (ui & 1) * 1024, lane); }
        const int nk = has_next ? ((nxt.kr * ntq) & ~1) : ck;
        const char* nA = has_next ? (const char*)g.A + (GATHER ? (size_t)0 : (size_t)nxt.pm * tstep) + (size_t)nk * kstepA : cA; const char* nB = has_next ? (const char*)g.Bt + (size_t)nxt.pb * tstep + (size_t)nk * kstepB : cB;
        if constexpr (Epi::KT1) {
        static_assert(SP2 && !KROT, "the one-K-tile loop is the SP2 schedule without K rotation");
#define PG8_KT1_TRIP(MMA_) do { \
            const int b = t & 1, t1 = t + 1, t2 = t + 2; \
            asm volatile("" : "+v"(voffA[0]), "+v"(voffA[1]), "+v"(voffB[0]), "+v"(voffB[1])); \
            const char* a1 = (t1 < nt) ? cA + (size_t)t1 * kstepA : nA; \
            const char* a2 = (t2 < nt) ? cA + (size_t)t2 * kstepA : nA + (size_t)(t2 - nt) * kstepA; const char* b2 = (t2 < nt) ? cB + (size_t)t2 * kstepB : nB + (size_t)(t2 - nt) * kstepB; \
            if (t == nt - 2 && has_next) S.a_ready(nxt); \
              \
            PG8_LDB(B0, b, 0); PG8_LDB(B1, b, 1); PG8_SCHED; PG8_LDA(At, b, 0); PG8_STAGE_A(PG8_SA(b ^ 1, 1), a1, 1); \
            if constexpr (GATHER) { if (t == nt - 2 && has_next) { \
                _Pragma("unroll") for (int h_ = 0; h_ < 2; ++h_) _Pragma("unroll") for (int i_ = 0; i_ < 2; ++i_) { int R_, C_; stage_rc(tid * 16 + i_ * 8192, R_, C_); const int rr_ = h_ * HALF + R_; \
                    const int a_ = (rr_ < nxt.gc) ? *(const PG8_LAS int*)(par + 2048 + rr_ * 4) : 0; offC[h_][i_] = (unsigned)((a_ >> 2) * K + C_) * 2u; } } } \
            PG8_WAIT_V(8); PG8_WAIT_L(0); PG8_BAR; MMA_(0, 0, At, B0); MMA_(0, 1, At, B1); PG8_BAR; PG8_SCHED; \
              \
            PG8_LDA(At, b, 1); PG8_STAGE(PG8_SB(b, 0), b2, voffB); PG8_STAGE(PG8_SB(b, 1), b2 + hstepB, voffB); PG8_STAGE_A(PG8_SA(b, 0), a2, 0); \
            PG8_WAIT_V(8); PG8_WAIT_L(0); PG8_BAR; MMA_(1, 0, At, B0); MMA_(1, 1, At, B1); PG8_BAR; PG8_SCHED; } while (0)
        { const int t = 0; PG8_KT1_TRIP(PG8_MMAZ); }
#pragma unroll 1
        for (int t = 1; t < nt; ++t) PG8_KT1_TRIP(PG8_MMA);
#undef PG8_KT1_TRIP
        } else
#pragma unroll 1
        for (int t = 0; t < nt; t += 2) {
            const bool last = (t == nt - 2);
            if constexpr (Epi::FP8) asm volatile("" : "+v"(voffA[0]), "+v"(voffA[1]), "+v"(voffB[0]), "+v"(voffB[1]));
            const long s1_ = ((ck + t + 1) & ntm) - ck, s2_ = ((ck + t + 2) & ntm) - ck; const long d1 = s1_ * (long)kstepA, d2 = s2_ * (long)kstepA, d2b = s2_ * (long)kstepB;
            const char* a1 = cA + d1;
            const char* a2 = last ? nA : cA + d2; const char* b2 = last ? nB : cB + d2b;
            const char* a3 = a2 + kstepA; const char* b3 = b2 + kstepB;
            if (last && has_next) S.a_ready(nxt);
            if constexpr (SP2) {
            PG8_LDB(B0, 0, 0); PG8_LDB(B1, 0, 1); PG8_SCHED; PG8_LDA(At, 0, 0); PG8_STAGE_A(PG8_SA(1, 1), a1, 1);
            if constexpr (GATHER) { if (last && has_next) {
                _Pragma("unroll") for (int h_ = 0; h_ < 2; ++h_) _Pragma("unroll") for (int i_ = 0; i_ < 2; ++i_) { int R_, C_; stage_rc(tid * 16 + i_ * 8192, R_, C_); const int rr_ = h_ * HALF + R_;
                    const int a_ = (rr_ < nxt.gc) ? *(const PG8_LAS int*)(par + 2048 + rr_ * 4) : 0; offC[h_][i_] = (unsigned)((a_ >> 2) * K + C_) * 2u; } } }
            PG8_WAIT_V(8); PG8_WAIT_L(0); PG8_BAR; PG8_MMA(0, 0, At, B0); PG8_MMA(0, 1, At, B1); PG8_BAR; PG8_SCHED;
            PG8_LDA(At, 0, 1); PG8_STAGE(PG8_SB(0, 0), b2, voffB); PG8_STAGE(PG8_SB(0, 1), b2 + hstepB, voffB); PG8_STAGE_A(PG8_SA(0, 0), a2, 0);
            PG8_WAIT_V(8); PG8_WAIT_L(0); PG8_BAR; PG8_MMA(1, 0, At, B0); PG8_MMA(1, 1, At, B1); PG8_BAR; PG8_SCHED;
            PG8_LDB(B0, 1, 0); PG8_LDB(B1, 1, 1); PG8_SCHED; PG8_LDA(At, 1, 0); PG8_STAGE_A(PG8_SA(0, 1), a2, 1);
            PG8_WAIT_V(8); PG8_WAIT_L(0); PG8_BAR; PG8_MMA(0, 0, At, B0); PG8_MMA(0, 1, At, B1); PG8_BAR; PG8_SCHED;
            PG8_LDA(At, 1, 1); PG8_STAGE(PG8_SB(1, 0), b3, voffB); PG8_STAGE(PG8_SB(1, 1), b3 + hstepB, voffB); PG8_STAGE_A(PG8_SA(1, 0), a3, 0);
            PG8_WAIT_V(8); PG8_WAIT_L(0); PG8_BAR; PG8_MMA(1, 0, At, B0); PG8_MMA(1, 1, At, B1); PG8_BAR; PG8_SCHED;
            } else {
            PG8_LDB(B0, 0, 0); PG8_SCHED; PG8_LDA(At, 0, 0); PG8_STAGE(PG8_SA(1, 1), a1 + hstep, voffA);
            PG8_WAIT_L(8); PG8_BAR; PG8_WAIT_L(0); PG8_MMA(0, 0, At, B0); PG8_BAR; PG8_SCHED;
            PG8_LDB(B1, 0, 1); PG8_STAGE(PG8_SB(0, 0), b2, voffB);
            PG8_BAR; PG8_WAIT_L(0); PG8_MMA(0, 1, At, B1); PG8_BAR;
            PG8_LDA(At, 0, 1); PG8_STAGE(PG8_SA(0, 0), a2, voffA);
            PG8_BAR; PG8_WAIT_L(0); PG8_MMA(1, 0, At, B0); PG8_BAR; PG8_SCHED;
            PG8_STAGE(PG8_SB(0, 1), b2 + hstep, voffB);
            PG8_WAIT_V(6); PG8_BAR; PG8_MMA(1, 1, At, B1); PG8_BAR;
            PG8_LDB(B0, 1, 0); PG8_SCHED; PG8_LDA(At, 1, 0); PG8_STAGE(PG8_SA(0, 1), a2 + hstep, voffA);
            PG8_WAIT_L(8); PG8_BAR; PG8_WAIT_L(0); PG8_MMA(0, 0, At, B0); PG8_BAR; PG8_SCHED;
            PG8_LDB(B1, 1, 1); PG8_STAGE(PG8_SB(1, 0), b3, voffB);
            PG8_BAR; PG8_WAIT_L(0); PG8_MMA(0, 1, At, B1); PG8_BAR;
            PG8_LDA(At, 1, 1); PG8_STAGE(PG8_SA(1, 0), a3, voffA);
            PG8_BAR; PG8_WAIT_L(0); PG8_MMA(1, 0, At, B0); PG8_BAR; PG8_SCHED;
            PG8_STAGE(PG8_SB(1, 1), b3 + hstep, voffB);
            PG8_WAIT_V(6); PG8_BAR; PG8_MMA(1, 1, At, B1); PG8_BAR;
            }
        }
        if constexpr (ALIGN_EPI) { if (wr == 0) PG8_BAR; }
        if constexpr (!Epi::AFTER_DRAIN) { int fr2, fq2; if constexpr (Epi::FP8) { const int l2_ = tid_of(0); fr2 = l2_ & 15; fq2 = l2_ >> 4; } else { fr2 = fr; fq2 = fq; asm volatile("" : "+v"(fr2), "+v"(fq2)); }
            if constexpr (Epi::LDS_PARAMS) E(acc, cur, wr, wc, fr2, fq2, par + (ui & 1) * 1024); else E(acc, cur, wr, wc, fr2, fq2);
            S.done(cur); }
        if (!has_next) break;
        if constexpr (!Epi::KT1)
#pragma unroll
        for (int a = 0; a < 2; ++a)
#pragma unroll
            for (int b = 0; b < 2; ++b)
#pragma unroll
                for (int m = 0; m < 4; ++m)
#pragma unroll
                    for (int n = 0; n < 2; ++n) acc[a][b][m][n] = (f32x4){0.f, 0.f, 0.f, 0.f};
        cur = nxt; cA = nA; cB = nB; ck = nk; ++ui;
        if constexpr (ALIGN_EPI) { if (wr == 1) PG8_BAR; }
    }
    PG8_WAIT_V(0);
    if constexpr (!ALIGN_EPI) { if (wr == 0) PG8_BAR; }
    PG8_BAR;
    if constexpr (Epi::AFTER_DRAIN) { E.fused(acc, cur, wr, wc, fr, fq, lds, wid, lane); S.done(cur); }
#undef PG8_SA
#undef PG8_SB
#undef PG8_STAGE
#undef PG8_STAGE_A
#undef PG8_GOFF
#undef PG8_LDA
#undef PG8_LDB
#undef PG8_MMA
#undef PG8_MMAZ
#undef PG8_CAT
#undef PG8_WAIT_V
#undef PG8_WAIT_L
#undef PG8_BAR
#undef PG8_SCHED
}
}

#define GAS __attribute__((address_space(1)))
#define LAS __attribute__((address_space(3)))
typedef unsigned short bf16;
typedef unsigned v4u __attribute__((ext_vector_type(4)));
typedef float f32x4 __attribute__((ext_vector_type(4)));
typedef short bf16x8 __attribute__((ext_vector_type(8)));
typedef GAS unsigned gu32;
typedef GAS unsigned long long gu64;
#define RLX_AGENT __ATOMIC_RELAXED, __HIP_MEMORY_SCOPE_AGENT
#define LDS_WAIT() asm volatile("s_waitcnt lgkmcnt(0)" ::: "memory")
#define VM_WAIT() asm volatile("s_waitcnt vmcnt(0)" ::: "memory")
__device__ __forceinline__ unsigned long long rt() { return __builtin_amdgcn_s_memrealtime(); }
__device__ __forceinline__ unsigned f2bf(float f) { unsigned u = __builtin_bit_cast(unsigned, f); return (u + 0x7fffu + ((u >> 16) & 1u)) >> 16; }
__device__ __forceinline__ unsigned pk2(float lo, float hi) { return f2bf(lo) | (f2bf(hi) << 16); }

#define XB_TMO      128
#define XB_XCNT(j)  (256  + 64 * (j))
#define XB_XSUB(j)  (1280 + 64 * (j))
#define XB_XGEN(j)  (2304 + 64 * (j))
#define XB_TOP      3328
#define XB_TOPGEN   3392
#define XCD_BAR_WORDS 3456
#define XB_SPIN_CAP (1u << 20)

__device__ __forceinline__ unsigned xb_ld(unsigned* p)              { return __hip_atomic_load((GAS unsigned*)p, __ATOMIC_RELAXED, __HIP_MEMORY_SCOPE_AGENT); }
__device__ __forceinline__ unsigned xb_add(unsigned* p, unsigned v) { return __hip_atomic_fetch_add((GAS unsigned*)p, v, __ATOMIC_RELAXED, __HIP_MEMORY_SCOPE_AGENT); }
__device__ __forceinline__ unsigned xb_xcc_id() { return (unsigned)__builtin_amdgcn_s_getreg((3 << 11) | 20) & 0xFu; }
#define XB_SPIN(cond, bar) do { unsigned _sp = 0; while (cond) { __builtin_amdgcn_s_sleep(1); \
    if ((++_sp & 255u) == 0u) { if (xb_ld(&(bar)[XB_TMO])) break; if (_sp > XB_SPIN_CAP) { (void)xb_add(&(bar)[XB_TMO], 1u); break; } } } } while (0)

struct XcdBarrier {
    int wave_s;
    unsigned* bar; unsigned x;
    volatile LAS unsigned* st;
};

__device__ __forceinline__ XcdBarrier xcd_barrier_post(unsigned* bar, volatile LAS unsigned* st, int wave_s) {
    XcdBarrier b; b.wave_s = wave_s; b.bar = bar; b.x = xb_xcc_id(); b.st = st;
    if (tid_of(wave_s) == 0) (void)xb_add(&bar[XB_XCNT(b.x)], 1u);
    return b;
}
__device__ __forceinline__ void xcd_barrier_complete(unsigned* bar, unsigned x, unsigned& nloc, unsigned& nx) {
    const unsigned G = gridDim.x * gridDim.y * gridDim.z;
    unsigned sum, cnt, mine, sp = 0u;
    for (;;) {
        sum = 0u; cnt = 0u; mine = 0u;
#pragma unroll
        for (unsigned j = 0; j < 16; ++j) { const unsigned c = xb_ld(&bar[XB_XCNT(j)]); sum += c; cnt += (c > 0u) ? 1u : 0u; mine = (j == x) ? c : mine; }
        if (sum == G) break;
        __builtin_amdgcn_s_sleep(1);
        if ((++sp & 255u) == 0u) { if (xb_ld(&bar[XB_TMO])) break; if (sp > XB_SPIN_CAP) { (void)xb_add(&bar[XB_TMO], 1u); break; } }
    }
    nloc = mine > 0u ? mine : 1u; nx = cnt > 0u ? cnt : 1u;
}

__device__ __forceinline__ void xcd_barrier(const XcdBarrier& b) {
    asm volatile("s_waitcnt vmcnt(0)" ::: "memory");
    __syncthreads();
    if (tid_of(b.wave_s) == 0) {
        unsigned* bar = b.bar; asm volatile("" : "+s"(bar));
        __builtin_amdgcn_s_waitcnt(0);
        unsigned nloc = b.st[0], nx = b.st[1];
        if (nloc == 0u) { xcd_barrier_complete(bar, b.x, nloc, nx); b.st[0] = nloc; b.st[1] = nx; }
        const unsigned old = xb_add(&bar[XB_XSUB(b.x)], 1u);
        const unsigned gen = old / nloc;
        if (old + 1u == (gen + 1u) * nloc) {
            __builtin_amdgcn_fence(__ATOMIC_RELEASE, "agent");
            asm volatile("s_waitcnt vmcnt(0)" ::: "memory");
            const unsigned og = xb_add(&bar[XB_TOP], 1u);
            const unsigned tg = og / nx;
            if (og + 1u == (tg + 1u) * nx) xb_add(&bar[XB_TOPGEN], 1u);
            else XB_SPIN(xb_ld(&bar[XB_TOPGEN]) == tg, bar);
            __builtin_amdgcn_fence(__ATOMIC_ACQUIRE, "agent");
            xb_add(&bar[XB_XGEN(b.x)], 1u);
            asm volatile("s_waitcnt vmcnt(0)" ::: "memory");
        } else {
            XB_SPIN(xb_ld(&bar[XB_XGEN(b.x)]) == gen, bar);
            __builtin_amdgcn_fence(__ATOMIC_ACQUIRE, "agent");
            asm volatile("s_waitcnt vmcnt(0)" ::: "memory");
        }
    }
    __syncthreads();
}


constexpr int NWAVES = 8, NTHR = 512;
constexpr int BATCH = 32, SEQ = 2048, T = BATCH * SEQ, D = 1024, DEPTH = 4, N_A = 2;
constexpr int HGH = 8, HGD = 128;
constexpr int MH = 16, QR = 256, KVR = 128, QKD = 192, VD = 128;
constexpr int NE = 32, TOPK = 4, FF = 1024;
constexpr int NASSIGN = T * TOPK, MAXTILES = NASSIGN / 256 + NE, MAXROWS = MAXTILES * 256;
constexpr float DN_ALPHA = 1.6817928305074290f;
constexpr float LN_EPS = 1e-5f, RMS_EPS = 1e-6f;
constexpr float QSCALE = 0.07216878364870322f * 1.4426950408889634f;

constexpr size_t MiB = 1u << 20;
constexpr size_t WS_CTL = 0, CTL_ZERO_BYTES = 1 * MiB;
constexpr size_t WS_LBTAB = 1 * MiB;
constexpr size_t WS_ROPE = 2 * MiB;
constexpr size_t WS_HGWIN = 18 * MiB;
constexpr size_t WS_HGWO = 34 * MiB;
constexpr size_t WS_DQ = 38 * MiB;
constexpr size_t WS_UQ = 39 * MiB;
constexpr size_t WS_MWO = 42 * MiB;
constexpr size_t WS_KVA = 50 * MiB;
constexpr size_t WS_W1 = 64 * MiB;
constexpr size_t WS_X8 = 320 * MiB;
constexpr size_t WS_RIMG = 385 * MiB;
constexpr size_t RIMG_STRIDE = 2 * 32 * 1024 * 2 + 256;
constexpr size_t WS_STATS = 384 * MiB;
constexpr size_t WS_W2 = 576 * MiB;
constexpr size_t WS_XB = 832 * MiB;
constexpr size_t WS_TBUF = 960 * MiB;
constexpr size_t WS_BIG = 1216 * MiB;
constexpr size_t WS_ABUF = 1744 * MiB;
constexpr size_t WS_CKVT = 2272 * MiB;
constexpr size_t WS_CVT8 = 2320 * MiB;
constexpr size_t WS_CK8 = 2304 * MiB;
constexpr size_t WS_CKV = 2784 * MiB;
constexpr size_t WS_CQ = 2816 * MiB;
constexpr int ECAP = T;
constexpr size_t WS_RSLOT = 2848 * MiB;
constexpr size_t WS_ASG = 2856 * MiB;
constexpr size_t WS_AGATE = 2857 * MiB;
constexpr size_t WS_END = 2858 * MiB;
static_assert((size_t)MAXROWS * 1024 * 2 <= 528 * MiB && (size_t)NE * ECAP * 4 <= 8 * MiB, "ws map");
constexpr int CW_TMO = 0, CW_CODE = 1, CW_BAR = 4096, CW_CNT = 8192;
static_assert((CW_CNT + DEPTH * NE * 16) * 4 <= (int)CTL_ZERO_BYTES, "ctl");

constexpr int RING_OFF = 0, RING_BYTES = 131072;
constexpr int LDS_BYTES = 163840;
constexpr int LDSCTL_OFF = LDS_BYTES - 512, MISC_OFF = LDSCTL_OFF + 320;
constexpr int R1_WROW = 2064, R1_WHI = 0, R1_WLO = 32 * R1_WROW, R1_STAT = 2 * 32 * R1_WROW, R1_S12 = R1_STAT + 2048, R1_RED = R1_S12 + 256, R1_END = R1_RED + 4096;
constexpr int GP_OFF = RING_BYTES;
constexpr int TAB_OFF = R1_END;
constexpr int TAB_TSTART = TAB_OFF, TAB_TILEE = TAB_OFF + 256, TAB_LCNT = TAB_TILEE + 1280, TAB_LBASE = TAB_LCNT + 128, TAB_AE = TAB_LBASE + 128, TAB_ARANK = TAB_AE + 4096, TAB_AG = TAB_ARANK + 4096, TAB_END = TAB_AG + 4096;
static_assert(R1_END >= RING_BYTES + 3072 && TAB_END <= LDSCTL_OFF && R1_END % 16 == 0, "LDS map");
static_assert(MAXTILES <= 1280, "LDS map");

struct Args {
    const float* x; const int* pos; const float* ln_g; const float* ln_b; const float* hg_w_in; const float* hg_lb; const float* hg_gnorm; const float* hg_w_o;
    const float* mla_w_dq; const float* mla_q_norm; const float* mla_w_uq; const float* mla_w_o; const float* kv_w_a; const float* kv_norm; const float* kv_w_b;
    const float* router_w; const float* router_b; const float* moe_w1; const float* moe_b1; const float* moe_w2; const float* moe_b2;
    float* out; unsigned char* ws; int st_lo, st_hi, single, pad;
};

__device__ __forceinline__ float wave_sum(float v) {
#pragma unroll
    for (int o = 1; o < 64; o <<= 1) v += __shfl_xor(v, o);
    return v;
}
__device__ __forceinline__ float bf2f(unsigned short b) { return __builtin_bit_cast(float, (unsigned)b << 16); }
__device__ __forceinline__ float bflo(unsigned w) { return __builtin_bit_cast(float, w << 16); }
__device__ __forceinline__ float bfhi(unsigned w) { return __builtin_bit_cast(float, w & 0xffff0000u); }
typedef float f32x2_t __attribute__((ext_vector_type(2))); typedef __bf16 bf16x2_t __attribute__((ext_vector_type(2)));
__device__ __forceinline__ unsigned cvtpk(float lo, float hi) { const f32x2_t v = {lo, hi}; const bf16x2_t b = __builtin_convertvector(v, bf16x2_t); return __builtin_bit_cast(unsigned, b); }

__device__ __forceinline__ int map_row(int mode, int n) {
    if (mode == 1) { const int h = n / 192, r = n - h * 192; if (r < 128) return n; const int j = r - 128; return h * 192 + 128 + 2 * (j & 31) + (j >> 5); }
    if (mode == 2) { if (n < 128) return n; const int j = n - 128; return 128 + 2 * (j & 31) + (j >> 5); }
    return n;
}
__device__ __forceinline__ size_t wt_off(int n, int k, int ldk) { return ((size_t)(n >> 4) * (ldk >> 5) + (k >> 5)) * 512 + (n & 15) * 32 + (k & 31); }
__device__ __forceinline__ void transpose_item(const float* W, int K, int N, bf16* WT, int ldk, int mode, LAS float* scr, int item, int lane) {
    const int nblk = N / 64, kb = item / nblk, nb = item % nblk, k0 = 64 * kb, n0 = 64 * nb;
#pragma unroll 16
    for (int kk = 0; kk < 64; ++kk) scr[kk * 65 + lane] = W[(size_t)(k0 + kk) * N + n0 + lane];
    LDS_WAIT(); asm volatile("" ::: "memory");
    const int nl = lane >> 2, c4 = lane & 3;
#pragma unroll
    for (int blk = 0; blk < 8; ++blk) { const int n = 16 * (blk >> 1) + nl, kl = 32 * (blk & 1) + 8 * c4; const LAS float* s = scr + kl * 65 + n;
        v4u o; o.x = cvtpk(s[0 * 65], s[1 * 65]); o.y = cvtpk(s[2 * 65], s[3 * 65]); o.z = cvtpk(s[4 * 65], s[5 * 65]); o.w = cvtpk(s[6 * 65], s[7 * 65]);
        if (mode != 1 || ((n0 + n) % 192) >= 128) *(GAS v4u*)(WT + wt_off(map_row(mode, n0 + n), k0 + kl, ldk)) = o; }
    LDS_WAIT(); asm volatile("" ::: "memory");
}
__device__ __forceinline__ void transpose_item8(const float* W, int K, int N, unsigned char* WT, float sc, LAS float* scr, int item, int lane) {
    const int nblk = N / 64, kb = item / nblk, nb = item % nblk, k0 = 64 * kb, n0 = 64 * nb;
#pragma unroll 16
    for (int kk = 0; kk < 64; ++kk) scr[kk * 65 + lane] = W[(size_t)(k0 + kk) * N + n0 + lane];
    LDS_WAIT(); asm volatile("" ::: "memory");
    const int nl = lane >> 2, c4 = lane & 3;
#pragma unroll
    for (int blk = 0; blk < 4; ++blk) { const LAS float* s = scr + (16 * c4) * 65 + 16 * blk + nl; unsigned o[4];
#pragma unroll
        for (int j = 0; j < 4; ++j) { o[j] = __builtin_amdgcn_cvt_pk_fp8_f32(s[(4 * j) * 65] * sc, s[(4 * j + 1) * 65] * sc, 0u, false); o[j] = __builtin_amdgcn_cvt_pk_fp8_f32(s[(4 * j + 2) * 65] * sc, s[(4 * j + 3) * 65] * sc, o[j], true); }
        *(GAS v4u*)(WT + ((size_t)(4 * nb + blk) * (K >> 6) + kb) * 1024 + nl * 64 + 16 * c4) = (v4u){o[0], o[1], o[2], o[3]}; }
    LDS_WAIT(); asm volatile("" ::: "memory");
}
__device__ __forceinline__ void p0_prologue(const Args& A, LAS unsigned char* lds, int vcu, int G, int wave, int lane, int tid) {
    unsigned char* ws = A.ws;
    LAS float* scr = (LAS float*)(lds + RING_OFF + wave * 16640);
    const int gw = vcu * NWAVES + wave, NGW = G * NWAVES;
    constexpr int I_W1 = 128 * 16 * 32, I_W2 = 128 * 16 * 16, I_HIN = 2 * 16 * 64, I_HWO = 2 * 16 * 16, I_DQ = 2 * 16 * 4, I_UQ = 2 * 4 * 48, I_KVA = 16 * 3;
    constexpr int NITEMS = I_W1 + I_W2 + I_HIN + I_HWO + I_DQ + I_UQ + I_KVA;
    for (int it = gw; it < NITEMS; it += NGW) {
        int r = it;
        if (r < I_W1) { const int mat = r >> 9; transpose_item8(A.moe_w1 + (size_t)mat * 1024 * 2048, 1024, 2048, ws + WS_W1 + (size_t)mat * 2048 * 1024, pg8::W1_SC, scr, r & 511, lane); continue; } r -= I_W1;
        if (r < I_W2) { const int mat = r >> 8; transpose_item8(A.moe_w2 + (size_t)mat * 1024 * 1024, 1024, 1024, ws + WS_W2 + (size_t)mat * 1024 * 1024, pg8::W2_SC, scr, r & 255, lane); continue; } r -= I_W2;
        if (r < I_HIN) { const int mat = r / 1024; transpose_item8(A.hg_w_in + (size_t)mat * 1024 * 4096, 1024, 4096, ws + WS_HGWIN + (size_t)mat * 4096 * 1024, pg8::HIN_SC, scr, r % 1024, lane); continue; } r -= I_HIN;
        if (r < I_HWO) { const int mat = r / 256; transpose_item8(A.hg_w_o + (size_t)mat * 1024 * 1024, 1024, 1024, ws + WS_HGWO + (size_t)mat * 1024 * 1024, pg8::HWO_SC, scr, r % 256, lane); continue; } r -= I_HWO;
        if (r < I_DQ) { const int mat = r / 64; transpose_item(A.mla_w_dq + (size_t)mat * 1024 * 256, 1024, 256, (bf16*)(ws + WS_DQ) + (size_t)mat * 256 * 1024, 1024, 0, scr, r % 64, lane); continue; } r -= I_DQ;
        if (r < I_UQ) { const int mat = r / 192; transpose_item(A.mla_w_uq + (size_t)mat * 256 * 3072, 256, 3072, (bf16*)(ws + WS_UQ) + (size_t)mat * 3072 * 256, 256, 1, scr, r % 192, lane); continue; } r -= I_UQ;
        transpose_item(A.kv_w_a, 1024, 192, (bf16*)(ws + WS_KVA), 1024, 2, scr, r, lane);
    }
    const int gt = vcu * NTHR + tid, NGT = G * NTHR;
    for (int i = gt; i < 8192; i += NGT) *(GAS v4u*)(ws + WS_KVA + (size_t)192 * 2048 + (size_t)i * 16) = (v4u){0u, 0u, 0u, 0u};
    for (int i = gt; i < 2048; i += NGT) { float v = 0.f; if (i >= 1024) { const float a = A.hg_lb[i - 1024], b = A.hg_lb[i]; v = 1.0f / (1.0f + expf(a - b)); } ((float*)(ws + WS_LBTAB))[i] = v; }
    for (int i = gt; i < T * 32; i += NGT) { const int tok = i >> 5, j = i & 31; const float inv = exp2f(-(float)j * (13.287712379549449f / 32.0f)); const float ang = (float)A.pos[tok] * inv; const double rev = (double)ang * 0.15915494309189535; const float fr = (float)(rev - rint(rev)); const float s = __builtin_amdgcn_sinf(fr), c = __builtin_amdgcn_cosf(fr);
        ((float2*)(ws + WS_ROPE))[i] = make_float2(c, s); }
    for (int it = vcu; it < 2 * 32 * 8; it += G) {
        const int kind = it >> 8, pj = (it >> 7) & 1, ph = (it >> 3) & 15, part = it & 7, r = tid & 127, q4 = tid >> 7;
        if (kind == 0) {
            const float* bw = A.kv_w_b + (size_t)r * 4096 + ph * 256; const float* aw = A.mla_w_uq + (size_t)pj * 256 * 3072 + (size_t)(32 * part + 8 * q4) * 3072 + ph * 192;
            float acc8[8] = {0.f, 0.f, 0.f, 0.f, 0.f, 0.f, 0.f, 0.f};
            for (int n = 0; n < 128; n += 4) { const f32x4 bv4 = *(const f32x4*)(bw + n);
#pragma unroll
                for (int i = 0; i < 8; ++i) { const f32x4 av4 = *(const f32x4*)(aw + (size_t)i * 3072 + n); acc8[i] += (av4.x * bv4.x + av4.y * bv4.y) + (av4.z * bv4.z + av4.w * bv4.w); } }
            *(GAS v4u*)((bf16*)(ws + WS_UQ) + (size_t)pj * 3072 * 256 + wt_off(ph * 192 + r, 32 * part + 8 * q4, 256)) = (v4u){cvtpk(acc8[0], acc8[1]), cvtpk(acc8[2], acc8[3]), cvtpk(acc8[4], acc8[5]), cvtpk(acc8[6], acc8[7])};
        } else {
            const float* bw = A.kv_w_b + (size_t)r * 4096 + ph * 256 + 128; const float* ow = A.mla_w_o + (size_t)pj * 2048 * 1024 + (size_t)(ph * 128) * 1024 + 128 * part + 32 * q4;
            float acc32[32];
#pragma unroll
            for (int i = 0; i < 32; ++i) acc32[i] = 0.f;
            for (int vd = 0; vd < 128; ++vd) { const float bvv = bw[vd];
#pragma unroll
                for (int i4 = 0; i4 < 8; ++i4) { const f32x4 w4 = *(const f32x4*)(ow + (size_t)vd * 1024 + 4 * i4); acc32[4 * i4] += bvv * w4.x; acc32[4 * i4 + 1] += bvv * w4.y; acc32[4 * i4 + 2] += bvv * w4.z; acc32[4 * i4 + 3] += bvv * w4.w; } }
            unsigned char* op_ = ws + WS_MWO + (size_t)pj * 1024 * 2048;
#pragma unroll
            for (int i = 0; i < 32; ++i) { const int n_ = 128 * part + 32 * q4 + i, k_ = ph * 128 + r; *(GAS unsigned char*)(op_ + ((size_t)(n_ >> 4) * 32 + (k_ >> 6)) * 1024 + (n_ & 15) * 64 + (k_ & 63)) = (unsigned char)(__builtin_amdgcn_cvt_pk_fp8_f32(acc32[i] * pg8::MWO_SC, 0.f, 0u, false) & 0xffu); }
        }
    }
    for (int it = gw; it < DEPTH * NE; it += NGW) { const int L = it / NE, e = it % NE; const float* rw = A.router_w + (size_t)L * D * NE; const float* lg = A.ln_g + (size_t)(L * 2 + 0) * D; const float* lb = A.ln_b + (size_t)(L * 2 + 0) * D;
        unsigned char* img = ws + WS_RIMG + (size_t)L * RIMG_STRIDE; float s1 = 0.f, s2 = 0.f;
#pragma unroll 4
        for (int k = 0; k < 16; ++k) { const int c = lane + 64 * k; const float w = rw[c * NE + e], wp = lg[c] * w; const unsigned hb = cvtpk(wp, 0.f) & 0xffffu; const float hf = __builtin_bit_cast(float, hb << 16);
            *(GAS unsigned short*)(img + (size_t)e * 2048 + c * 2) = (unsigned short)hb; *(GAS unsigned short*)(img + 65536 + (size_t)e * 2048 + c * 2) = (unsigned short)(cvtpk(wp - hf, 0.f) & 0xffffu);
            s1 += wp; s2 += lb[c] * w; }
        s1 = wave_sum(s1); s2 = wave_sum(s2);
        if (lane == 0) { *(GAS float*)(img + 131072 + e * 4) = s1; *(GAS float*)(img + 131072 + 128 + e * 4) = s2 + A.router_b[L * NE + e]; } }
    for (int m = gw; m < T; m += NGW) { const GAS f32x4* xr = (const GAS f32x4*)(A.x + (size_t)m * D) + lane; GAS unsigned long long* o8 = (GAS unsigned long long*)((bf16*)(ws + WS_XB) + (size_t)m * D) + lane;
#pragma unroll
        for (int j = 0; j < 4; ++j) { const f32x4 v = xr[64 * j]; o8[64 * j] = (unsigned long long)cvtpk(v.x, v.y) | ((unsigned long long)cvtpk(v.z, v.w) << 32);
            *(GAS unsigned*)(ws + WS_X8 + (size_t)m * D + 4 * lane + 256 * j) = __builtin_amdgcn_cvt_pk_fp8_f32(v.z, v.w, __builtin_amdgcn_cvt_pk_fp8_f32(v.x, v.y, 0u, false), true); } }
}

__device__ __forceinline__ void hg_scan_unit(const Args& A, int layer, int bh, LAS unsigned char* lds, int tid) {
    const int b = bh >> 3, h = bh & 7, v = tid & 127, kq = tid >> 7;
    const bf16* qfig = (const bf16*)(A.ws + WS_BIG); bf16* og = (bf16*)(A.ws + WS_ABUF);
    LAS float* Lq = (LAS float*)lds; LAS float* Lf = Lq + 4096; LAS float* Lk = Lf + 4096; LAS float* Li = Lk + 4096; LAS float* Po = Li + 4096;
    float S[32];
#pragma unroll
    for (int i = 0; i < 32; ++i) S[i] = 0.f;
    const int lt = tid >> 4, v0 = (tid & 15) * 8;
    f32x4 gn0 = *(const f32x4*)(A.hg_gnorm + layer * 128 + v0), gn1 = *(const f32x4*)(A.hg_gnorm + layer * 128 + v0 + 4);
    for (int t0 = 0; t0 < SEQ; t0 += 32) {
        const size_t rowoff = ((size_t)b * SEQ + t0 + lt) * 4096 + h * 128 + v0;
        const v4u wq = *(const GAS v4u*)(qfig + rowoff), wf = *(const GAS v4u*)(qfig + rowoff + 1024), wi = *(const GAS v4u*)(qfig + rowoff + 2048);
        const unsigned aq[4] = {wq.x, wq.y, wq.z, wq.w}, af[4] = {wf.x, wf.y, wf.z, wf.w}, ai[4] = {wi.x, wi.y, wi.z, wi.w};
#pragma unroll
        for (int j = 0; j < 4; ++j) { const int o = lt * 128 + v0 + 2 * j;
            Lq[o] = bflo(aq[j]); Lq[o + 1] = bfhi(aq[j]); Li[o] = bflo(ai[j]); Li[o + 1] = bfhi(ai[j]);
            const float f0 = __expf(bflo(af[j])), f1 = __expf(bfhi(af[j])); Lf[o] = f0; Lf[o + 1] = f1; Lk[o] = 1.0f - f0; Lk[o + 1] = 1.0f - f1; }
        __syncthreads();
        for (int t = 0; t < 32; ++t) {
            const float iv = Li[t * 128 + v]; float o = 0.f;
            const LAS f32x4* pf = (const LAS f32x4*)(Lf + t * 128 + kq * 32); const LAS f32x4* pk = (const LAS f32x4*)(Lk + t * 128 + kq * 32); const LAS f32x4* pq = (const LAS f32x4*)(Lq + t * 128 + kq * 32);
#pragma unroll
            for (int k4 = 0; k4 < 8; ++k4) { const f32x4 f4 = pf[k4], kk4 = pk[k4], q4 = pq[k4];
#pragma unroll
                for (int j = 0; j < 4; ++j) { S[4 * k4 + j] = f4[j] * S[4 * k4 + j] + kk4[j] * iv; o += S[4 * k4 + j] * q4[j]; } }
            Po[(kq * 32 + t) * 128 + v] = o;
        }
        __syncthreads();
        {
            float o8[8]; float ss = 0.f;
#pragma unroll
            for (int j = 0; j < 8; ++j) { o8[j] = (Po[(0 * 32 + lt) * 128 + v0 + j] + Po[(1 * 32 + lt) * 128 + v0 + j]) + (Po[(2 * 32 + lt) * 128 + v0 + j] + Po[(3 * 32 + lt) * 128 + v0 + j]); ss += o8[j] * o8[j]; }
            ss += __shfl_xor(ss, 1); ss += __shfl_xor(ss, 2); ss += __shfl_xor(ss, 4); ss += __shfl_xor(ss, 8);
            const float rstd = 1.0f / sqrtf(ss * (1.0f / 128.0f) + RMS_EPS);
            const v4u wg = *(const GAS v4u*)(qfig + rowoff + 3072); const unsigned ag[4] = {wg.x, wg.y, wg.z, wg.w};
            const float gn[8] = {gn0[0], gn0[1], gn0[2], gn0[3], gn1[0], gn1[1], gn1[2], gn1[3]};
            unsigned w[4];
#pragma unroll
            for (int j = 0; j < 4; ++j) w[j] = cvtpk(o8[2 * j] * rstd * gn[2 * j] * bflo(ag[j]), o8[2 * j + 1] * rstd * gn[2 * j + 1] * bfhi(ag[j]));
            *(GAS v4u*)(og + ((size_t)b * SEQ + t0 + lt) * 1024 + h * 128 + v0) = (v4u){w[0], w[1], w[2], w[3]};
        }
    }
    __syncthreads();
}

constexpr int HG_QROW = 288, HG_TROW = 80, HG_OROW = 132;
constexpr int HG_QD = 0, HG_KD = 32 * HG_QROW, HG_K2 = 2 * 32 * HG_QROW, HG_IV = HG_K2 + 128 * HG_TROW, HG_ER = HG_IV + 128 * HG_TROW, HG_EB = HG_ER + 512, HG_SET = HG_EB + 512;
constexpr int HG_OST = 2 * HG_SET, HG_OSTB = 32 * HG_OROW * 4, HG_RAW = HG_OST + 2 * HG_OSTB, HG_END = HG_RAW + 4 * 6144;
static_assert(HG_END <= R1_END && HG_SET % 16 == 0 && HG_OSTB % 16 == 0, "hgrn LDS");
typedef short s16x4 __attribute__((ext_vector_type(4)));
__device__ __forceinline__ void hg_chunk_unit(const Args& A, int layer, int bh, LAS unsigned char* lds, int tid) {
    const int b = bh >> 3, h = bh & 7;
    const int lane = tid & 63, w = __builtin_amdgcn_readfirstlane(tid >> 6);
    const bf16* qfig = (const bf16*)(A.ws + WS_BIG); bf16* og = (bf16*)(A.ws + WS_ABUF);
    constexpr int NCH = SEQ / 32;
    if (w < 4) {
        const int c = w * 32 + (lane & 31), half = lane >> 5;
        const int et = tid >> 3, ev0 = (tid & 7) * 16;
        const bf16* dsrc = qfig + ((size_t)(b * 128) * 128 + h * 4 + w) * 512 + lane * 8;
        LAS unsigned char* raw = lds + HG_RAW + w * 6144;
        const bf16* gp = qfig + ((size_t)(b * 128 + (et >> 4)) * 128 + 96 + h * 4 + (ev0 >> 5)) * 512 + (et & 15) * 32 + (ev0 & 31);
        unsigned char* op = (unsigned char*)og + ((size_t)b * SEQ + et) * 1024 + h * 128 + ev0;
        unsigned short rq[16], rf[16], ri[16];
#define HG_DMA(ch) do { const bf16* p_ = dsrc + (size_t)(ch) * 2 * 128 * 512; \
        _Pragma("unroll") for (int a = 0; a < 3; ++a) _Pragma("unroll") for (int j = 0; j < 2; ++j) \
            __builtin_amdgcn_global_load_lds((const unsigned*)(p_ + (size_t)j * 128 * 512 + a * 32 * 512), (LAS unsigned*)(raw + a * 2048 + j * 1024), 16, 0, 0); } while (0)
#define HG_LOAD(ch) do { const LAS unsigned char* r_ = raw + (16 * half) * 64 + (lane & 31) * 2; \
        _Pragma("unroll") for (int i = 0; i < 16; ++i) { rq[i] = *(const LAS unsigned short*)(r_ + i * 64); rf[i] = *(const LAS unsigned short*)(r_ + 2048 + i * 64); ri[i] = *(const LAS unsigned short*)(r_ + 4096 + i * 64); } } while (0)
#define HG_PRE(ch) do { int so_ = ((ch) & 1) * HG_SET; asm volatile("" : "+s"(so_)); LAS unsigned char* set = lds + so_; \
        float lf[16], bl[16]; float run = 0.f; \
        _Pragma("unroll") for (int i = 0; i < 16; ++i) { lf[i] = bf2f(rf[i]); run += lf[i]; bl[i] = run; } \
        const float oth = __shfl_xor(run, 32); const float off = half ? oth : 0.f, r = half ? oth : run, bL = run + oth, e3_ = __builtin_amdgcn_exp2f(bL - r); \
        unsigned k2[8]; \
        _Pragma("unroll") for (int i = 0; i < 16; i += 2) { float kd2v[2]; \
            _Pragma("unroll") for (int ii = 0; ii < 2; ++ii) { const float bb = off + bl[i + ii], kk = 1.0f - __builtin_amdgcn_exp2f(lf[i + ii]);        \
                const float qd = bf2f(rq[i + ii]) * __builtin_amdgcn_exp2f(bb - r), kd = kk * __builtin_amdgcn_exp2f(r - bb); kd2v[ii] = kd * e3_;        \
                *(LAS unsigned short*)(set + HG_QD + (16 * half + i + ii) * HG_QROW + c * 2) = (unsigned short)(cvtpk(qd, 0.f) & 0xffffu); \
                *(LAS unsigned short*)(set + HG_KD + (16 * half + i + ii) * HG_QROW + c * 2) = (unsigned short)(cvtpk(kd, 0.f) & 0xffffu); } \
            k2[i >> 1] = cvtpk(kd2v[0], kd2v[1]); } \
        *(LAS v4u*)(set + HG_K2 + c * HG_TROW + half * 32) = (v4u){k2[0], k2[1], k2[2], k2[3]}; *(LAS v4u*)(set + HG_K2 + c * HG_TROW + half * 32 + 16) = (v4u){k2[4], k2[5], k2[6], k2[7]}; \
        *(LAS v4u*)(set + HG_IV + c * HG_TROW + half * 32) = (v4u){(unsigned)ri[0] | ((unsigned)ri[1] << 16), (unsigned)ri[2] | ((unsigned)ri[3] << 16), (unsigned)ri[4] | ((unsigned)ri[5] << 16), (unsigned)ri[6] | ((unsigned)ri[7] << 16)}; \
        *(LAS v4u*)(set + HG_IV + c * HG_TROW + half * 32 + 16) = (v4u){(unsigned)ri[8] | ((unsigned)ri[9] << 16), (unsigned)ri[10] | ((unsigned)ri[11] << 16), (unsigned)ri[12] | ((unsigned)ri[13] << 16), (unsigned)ri[14] | ((unsigned)ri[15] << 16)}; \
        if (half == 0) { *(LAS float*)(set + HG_ER + c * 4) = __builtin_amdgcn_exp2f(r); *(LAS float*)(set + HG_EB + c * 4) = __builtin_amdgcn_exp2f(bL); } } while (0)
#define HG_EPI(ch, RG0, RG1) do { int oo_ = HG_OST + ((ch) & 1) * HG_OSTB; asm volatile("" : "+s"(oo_)); const LAS float* ost = (const LAS float*)(lds + oo_) + et * HG_OROW + ev0; \
        f32x4 ov[4], gn[4]; float ss = 0.f; \
        _Pragma("unroll") for (int i = 0; i < 4; ++i) gn[i] = *(const f32x4*)(A.hg_gnorm + layer * 128 + ev0 + 4 * i); \
        _Pragma("unroll") for (int i = 0; i < 4; ++i) { ov[i] = *(const LAS f32x4*)(ost + 4 * i); ss += (ov[i][0] * ov[i][0] + ov[i][1] * ov[i][1]) + (ov[i][2] * ov[i][2] + ov[i][3] * ov[i][3]); } \
        ss += __shfl_xor(ss, 1); ss += __shfl_xor(ss, 2); ss += __shfl_xor(ss, 4); \
        const float rstd = 1.0f / sqrtf(ss * (1.0f / 128.0f) + RMS_EPS); \
        const unsigned gw[8] = {RG0.x, RG0.y, RG0.z, RG0.w, RG1.x, RG1.y, RG1.z, RG1.w}; unsigned ow[8]; \
        _Pragma("unroll") for (int i = 0; i < 4; ++i) { const f32x4 y = ov[i] * rstd * gn[i] * pg8::OG_SC; ow[i] = __builtin_amdgcn_cvt_pk_fp8_f32(y[0] * bflo(gw[2 * i]), y[1] * bfhi(gw[2 * i]), 0u, false); ow[i] = __builtin_amdgcn_cvt_pk_fp8_f32(y[2] * bflo(gw[2 * i + 1]), y[3] * bfhi(gw[2 * i + 1]), ow[i], true); } \
        *(GAS v4u*)(op + (size_t)(ch) * 32 * 1024) = (v4u){ow[0], ow[1], ow[2], ow[3]}; } while (0)
        HG_DMA(0); asm volatile("s_waitcnt vmcnt(0)" ::: "memory");
        HG_LOAD(0); HG_PRE(0);
        asm volatile("s_waitcnt lgkmcnt(0)" ::: "memory"); HG_DMA(1);
        __syncthreads();
        for (int ch = 0; ch < NCH; ++ch) {
            v4u rg0 = {0u, 0u, 0u, 0u}, rg1 = rg0;
            if (ch >= 1) { rg0 = *(const GAS v4u*)(gp + (size_t)(ch - 1) * 2 * 128 * 512); rg1 = *(const GAS v4u*)(gp + (size_t)(ch - 1) * 2 * 128 * 512 + 8); }
            if (ch + 1 < NCH) { HG_LOAD(ch + 1); HG_PRE(ch + 1); if (ch + 2 < NCH) { asm volatile("s_waitcnt lgkmcnt(0)" ::: "memory"); HG_DMA(ch + 2); } }
            if (ch >= 1) HG_EPI(ch - 1, rg0, rg1);
            __syncthreads();
        }
        { const v4u rg0 = *(const GAS v4u*)(gp + (size_t)(NCH - 1) * 2 * 128 * 512), rg1 = *(const GAS v4u*)(gp + (size_t)(NCH - 1) * 2 * 128 * 512 + 8); HG_EPI(NCH - 1, rg0, rg1); }
#undef HG_DMA
#undef HG_LOAD
#undef HG_PRE
#undef HG_EPI
    } else {
        const int m = w - 4, l15 = lane & 15, quad = lane >> 4;
        f32x4 S[2][8];
#pragma unroll
        for (int j = 0; j < 2; ++j)
#pragma unroll
            for (int mt = 0; mt < 8; ++mt) S[j][mt] = (f32x4){0.f, 0.f, 0.f, 0.f};
        __syncthreads();
        for (int ch = 0; ch < NCH; ++ch) {
            int so_ = (ch & 1) * HG_SET; asm volatile("" : "+s"(so_));
            const LAS unsigned char* set = lds + so_;
            f32x4 c00 = {0.f, 0.f, 0.f, 0.f}, c01 = c00, c11 = c00;
            {   const LAS unsigned char* ka = set + HG_KD + l15 * HG_QROW + quad * 16; const LAS unsigned char* qa = set + HG_QD + l15 * HG_QROW + quad * 16;
                bf16x8 fa0[4], fa1[4], fb0[4], fb1[4];
#pragma unroll
                for (int ks = 0; ks < 4; ++ks) { fa0[ks] = *(const LAS bf16x8*)(ka + ks * 64); fa1[ks] = *(const LAS bf16x8*)(ka + 16 * HG_QROW + ks * 64); fb0[ks] = *(const LAS bf16x8*)(qa + ks * 64); fb1[ks] = *(const LAS bf16x8*)(qa + 16 * HG_QROW + ks * 64); }
                __builtin_amdgcn_sched_barrier(0);
#pragma unroll
                for (int ks = 0; ks < 4; ++ks) { c00 = __builtin_amdgcn_mfma_f32_16x16x32_bf16(fa0[ks], fb0[ks], c00, 0, 0, 0); c01 = __builtin_amdgcn_mfma_f32_16x16x32_bf16(fa0[ks], fb1[ks], c01, 0, 0, 0); c11 = __builtin_amdgcn_mfma_f32_16x16x32_bf16(fa1[ks], fb1[ks], c11, 0, 0, 0); } }
            f32x4 ea[4], eb4[4]; bf16x8 qa0[4], qa1[4];
            {   const LAS unsigned char* qa = set + HG_QD + l15 * HG_QROW + quad * 8; const LAS float* er = (const LAS float*)(set + HG_ER) + 4 * quad;
#pragma unroll
                for (int ks = 0; ks < 4; ++ks) { ea[ks] = *(const LAS f32x4*)(er + 32 * ks); eb4[ks] = *(const LAS f32x4*)(er + 32 * ks + 16);
                    const s16x4 a0l = *(const LAS s16x4*)(qa + ks * 64), a0h = *(const LAS s16x4*)(qa + ks * 64 + 32), a1l = *(const LAS s16x4*)(qa + 16 * HG_QROW + ks * 64), a1h = *(const LAS s16x4*)(qa + 16 * HG_QROW + ks * 64 + 32);
                    qa0[ks] = __builtin_shufflevector(a0l, a0h, 0, 1, 2, 3, 4, 5, 6, 7); qa1[ks] = __builtin_shufflevector(a1l, a1h, 0, 1, 2, 3, 4, 5, 6, 7); } }
            __builtin_amdgcn_sched_barrier(0);
#pragma unroll
            for (int j = 0; j < 4; ++j) { if (4 * quad + j > l15) { c00[j] = 0.f; c11[j] = 0.f; } }
            const v4u sa0 = {cvtpk(c00[0], c00[1]), cvtpk(c00[2], c00[3]), 0u, 0u}, sa1 = {cvtpk(c01[0], c01[1]), cvtpk(c01[2], c01[3]), cvtpk(c11[0], c11[1]), cvtpk(c11[2], c11[3])};
            f32x4 o[2][2];
#pragma unroll
            for (int j = 0; j < 2; ++j) { o[j][0] = (f32x4){0.f, 0.f, 0.f, 0.f}; o[j][1] = o[j][0]; }
#pragma unroll
            for (int ks = 0; ks < 4; ++ks)
#pragma unroll
                for (int j = 0; j < 2; ++j) { const f32x4 sa = S[j][2 * ks] * ea[ks], sb = S[j][2 * ks + 1] * eb4[ks];
                    const v4u bw = {cvtpk(sa[0], sa[1]), cvtpk(sa[2], sa[3]), cvtpk(sb[0], sb[1]), cvtpk(sb[2], sb[3])};
                    o[j][0] = __builtin_amdgcn_mfma_f32_16x16x32_bf16(qa0[ks], __builtin_bit_cast(bf16x8, bw), o[j][0], 0, 0, 0);
                    o[j][1] = __builtin_amdgcn_mfma_f32_16x16x32_bf16(qa1[ks], __builtin_bit_cast(bf16x8, bw), o[j][1], 0, 0, 0); }
            int oo_ = HG_OST + (ch & 1) * HG_OSTB; asm volatile("" : "+s"(oo_)); LAS float* ost = (LAS float*)(lds + oo_);
            bf16x8 k2f[8]; f32x4 d4[8]; bf16x8 ivp[2], ivn[2];
            {   const LAS float* eb = (const LAS float*)(set + HG_EB) + 4 * quad; const LAS unsigned char* k2a = set + HG_K2 + l15 * HG_TROW + quad * 16;
#pragma unroll
                for (int mt = 0; mt < 8; ++mt) { d4[mt] = *(const LAS f32x4*)(eb + 16 * mt); k2f[mt] = *(const LAS bf16x8*)(k2a + mt * 16 * HG_TROW); }
#pragma unroll
                for (int j = 0; j < 2; ++j) { const LAS unsigned char* ivr = set + HG_IV + (32 * m + 16 * j + l15) * HG_TROW;
                    const s16x4 pl = *(const LAS s16x4*)(ivr + quad * 8), ph = *(const LAS s16x4*)(ivr + 32 + quad * 8); ivp[j] = __builtin_shufflevector(pl, ph, 0, 1, 2, 3, 4, 5, 6, 7); ivn[j] = *(const LAS bf16x8*)(ivr + quad * 16); } }
            __builtin_amdgcn_sched_barrier(0);
#pragma unroll
            for (int j = 0; j < 2; ++j) {
                o[j][0] = __builtin_amdgcn_mfma_f32_16x16x32_bf16(__builtin_bit_cast(bf16x8, sa0), ivp[j], o[j][0], 0, 0, 0); o[j][1] = __builtin_amdgcn_mfma_f32_16x16x32_bf16(__builtin_bit_cast(bf16x8, sa1), ivp[j], o[j][1], 0, 0, 0);
#pragma unroll
                for (int mt = 0; mt < 8; ++mt) S[j][mt] = __builtin_amdgcn_mfma_f32_16x16x32_bf16(k2f[mt], ivn[j], S[j][mt] * d4[mt], 0, 0, 0);
            }
#pragma unroll
            for (int j = 0; j < 2; ++j)
#pragma unroll
                for (int jj = 0; jj < 4; ++jj) { ost[(4 * quad + jj) * HG_OROW + 32 * m + 16 * j + l15] = o[j][0][jj]; ost[(16 + 4 * quad + jj) * HG_OROW + 32 * m + 16 * j + l15] = o[j][1][jj]; }
            __syncthreads();
        }
    }
    __syncthreads();
}

typedef float f32x16 __attribute__((ext_vector_type(16)));
constexpr int AT_KROW = 200  , AT_VROW = 72  , AT_KB = 64 * AT_KROW, AT_VB = 128 * AT_VROW;
constexpr int AT_OST = 2 * (AT_KB + AT_VB) + 1024;
static_assert(2 * (AT_KB + AT_VB) <= RING_BYTES && AT_OST % 16 == 0 && AT_OST + 8 * 32 * 272 <= LDSCTL_OFF, "attention LDS");
__device__ __forceinline__ int crow(int r, int hi) { return (r & 3) + 8 * (r >> 2) + 4 * hi; }
struct AttnPre { pg8::u32x2 q8[12]; v4u st[5]; };
__device__ __forceinline__ void attn_prefetch(const Args& A, int b, int h, int qb, int tid, AttnPre& P, bool with_q = true, bool with_st = true) {
    asm volatile("" : "+v"(tid));
    const int lane = tid & 63, wid = __builtin_amdgcn_readfirstlane(tid >> 6), r32 = lane & 31, hi = lane >> 5;
    const bf16* qbuf = (const bf16*)(A.ws + WS_BIG); const bf16* ckv = (const bf16*)(A.ws + WS_CKV); const bf16* ckvT = (const bf16*)(A.ws + WS_CKVT);
    const size_t tokq = (size_t)b * SEQ + qb * 256 + wid * 32 + r32, tok0 = (size_t)b * SEQ;
    const unsigned char* Qp = (const unsigned char*)qbuf + ((tokq >> 4) * 96 + 6 * h) * 512 + (tokq & 15) * 32 + hi * 8;
    if (with_q) {
#pragma unroll
    for (int s = 0; s < 12; ++s) P.q8[s] = *(const GAS pg8::u32x2*)(Qp + (s >> 1) * 512 + (s & 1) * 16); }
    const bf16* kp = ckv + (tok0 + (tid >> 3)) * 256 + (tid & 7) * 8; const bf16* vp = ckvT + (size_t)(tid >> 2) * T + tok0 + (tid & 3) * 8;
    if (with_st) { P.st[0] = *(const GAS v4u*)(kp); P.st[1] = *(const GAS v4u*)(kp + 64); P.st[2] = *(const GAS v4u*)(kp + 128); P.st[3] = *(const GAS v4u*)(vp); P.st[4] = *(const GAS v4u*)(vp + 32); }
}
__device__ __forceinline__ void attn_unit(const Args& A, int b, int h, int qb, LAS unsigned char* lds, int tid, AttnPre& P, bool has_next, int nb, int nh, int nqb, bool st_ready) {
    asm volatile("" : "+v"(tid));
    const int lane = tid & 63, wid = __builtin_amdgcn_readfirstlane(tid >> 6), r32 = lane & 31, hi = lane >> 5;
    const bf16* qbuf = (const bf16*)(A.ws + WS_BIG); const bf16* ckv = (const bf16*)(A.ws + WS_CKV); const bf16* ckvT = (const bf16*)(A.ws + WS_CKVT);
    bf16* obuf = (bf16*)(A.ws + WS_ABUF);
    const int q0 = qb * 256, qrow = q0 + wid * 32 + r32; const size_t tokq = (size_t)b * SEQ + qrow;
    f32x16 o[4];
#pragma unroll
    for (int d = 0; d < 4; ++d)
#pragma unroll
        for (int i = 0; i < 16; ++i) o[d][i] = 0.f;
    float m_run = -1e30f, l_run = 0.f;
    const int NT = 4 * qb + 4;
    v4u st[5];
#pragma unroll
    for (int i = 0; i < 5; ++i) st[i] = (v4u){0u, 0u, 0u, 0u};
    const size_t tok0 = (size_t)b * SEQ;
    const unsigned char* kp = A.ws + WS_CK8 + (tok0 + (tid >> 3)) * 192 + (tid & 7) * 8;
    pg8::u32x2 k8[3];
    const unsigned char* vp = A.ws + WS_CVT8 + (size_t)(tid >> 2) * T + tok0 + (tid & 3) * 16;
    { k8[0] = *(const GAS pg8::u32x2*)(kp); k8[1] = *(const GAS pg8::u32x2*)(kp + 64); k8[2] = *(const GAS pg8::u32x2*)(kp + 128); st[3] = *(const GAS v4u*)(vp); kp += 64 * 192; vp += 64; }
    const int kdst = (tid >> 3) * AT_KROW + (tid & 7) * 8, vdst = AT_KB + (tid >> 2) * AT_VROW + (tid & 3) * 16; (void)ckvT; (void)ckv;
#define AT_LOAD(t) do { k8[0] = *(const GAS pg8::u32x2*)(kp); k8[1] = *(const GAS pg8::u32x2*)(kp + 64); k8[2] = *(const GAS pg8::u32x2*)(kp + 128); st[3] = *(const GAS v4u*)(vp); \
        kp += 64 * 192; vp += 64; } while (0)
#define AT_STORE(buf) do { LAS unsigned char* bb_ = lds + (buf) * (AT_KB + AT_VB); \
        *(LAS pg8::u32x2*)(bb_ + kdst) = k8[0]; *(LAS pg8::u32x2*)(bb_ + kdst + 64) = k8[1]; *(LAS pg8::u32x2*)(bb_ + kdst + 128) = k8[2]; typedef unsigned u2_ __attribute__((ext_vector_type(2)));   \
        *(LAS u2_*)(bb_ + vdst) = (u2_){st[3].x, st[3].y}; *(LAS u2_*)(bb_ + vdst + 8) = (u2_){st[3].z, st[3].w}; } while (0)
    AT_STORE(0);
    __builtin_amdgcn_sched_barrier(0);
    long qf[12];
#pragma unroll
    for (int s = 0; s < 12; ++s) qf[s] = __builtin_bit_cast(long, P.q8[s]);
    __syncthreads();
    for (int t = 0; t < NT; ++t) {
        const int buf = t & 1;
        if (t + 1 < NT) AT_LOAD(t + 1);
        if (64 * t <= q0 + wid * 32 + 31) {
            const LAS unsigned char* kb = lds + buf * (AT_KB + AT_VB) + r32 * AT_KROW + hi * 8;
            f32x16 s0, s1;
#pragma unroll
            for (int i = 0; i < 16; ++i) { s0[i] = 0.f; s1[i] = 0.f; }
#pragma unroll
            for (int sb4 = 0; sb4 < 12; sb4 += 4) { long ka[4], kc[4];
#pragma unroll
                for (int s = 0; s < 4; ++s) { ka[s] = *(const LAS long*)(kb + (sb4 + s) * 16); kc[s] = *(const LAS long*)(kb + 32 * AT_KROW + (sb4 + s) * 16); }
                __builtin_amdgcn_sched_barrier(0);
#pragma unroll
                for (int s = 0; s < 4; ++s) { s0 = __builtin_amdgcn_mfma_f32_32x32x16_fp8_fp8(ka[s], qf[sb4 + s], s0, 0, 0, 0); s1 = __builtin_amdgcn_mfma_f32_32x32x16_fp8_fp8(kc[s], qf[sb4 + s], s1, 0, 0, 0); }
                __builtin_amdgcn_sched_barrier(0); }
            if (64 * t + 63 > q0 + wid * 32) {
#pragma unroll
                for (int i = 0; i < 16; ++i) { const int key = 64 * t + crow(i, hi); if (key > qrow) s0[i] = -__builtin_inff(); if (key + 32 > qrow) s1[i] = -__builtin_inff(); }
            }
            float mx = s0[0];
#pragma unroll
            for (int i = 1; i < 16; ++i) mx = fmaxf(mx, s0[i]);
#pragma unroll
            for (int i = 0; i < 16; ++i) mx = fmaxf(mx, s1[i]);
            mx = fmaxf(mx, __shfl_xor(mx, 32)); constexpr float usc = 1.0f / (pg8::Q_SC * pg8::K_SC); mx *= usc;
            if (__any(mx > m_run + 8.0f)) {
                const float mn = fmaxf(m_run, mx), alpha = __builtin_amdgcn_exp2f(m_run - mn); m_run = mn; l_run *= alpha;
#pragma unroll
                for (int d = 0; d < 4; ++d)
#pragma unroll
                    for (int i = 0; i < 16; ++i) o[d][i] *= alpha; }
#pragma unroll
            for (int i = 0; i < 16; ++i) { s0[i] = __builtin_amdgcn_exp2f(__builtin_fmaf(s0[i], usc, -m_run)); s1[i] = __builtin_amdgcn_exp2f(__builtin_fmaf(s1[i], usc, -m_run)); }
            long pb[4]; float ps = 0.f;
#pragma unroll
            for (int s2 = 0; s2 < 2; ++s2) { pg8::u32x2 w0, w1;
                w0.x = __builtin_amdgcn_cvt_pk_bf8_f32(s0[8 * s2 + 0], s0[8 * s2 + 1], 0u, false); w0.x = __builtin_amdgcn_cvt_pk_bf8_f32(s0[8 * s2 + 2], s0[8 * s2 + 3], w0.x, true);
                w0.y = __builtin_amdgcn_cvt_pk_bf8_f32(s0[8 * s2 + 4], s0[8 * s2 + 5], 0u, false); w0.y = __builtin_amdgcn_cvt_pk_bf8_f32(s0[8 * s2 + 6], s0[8 * s2 + 7], w0.y, true);
                w1.x = __builtin_amdgcn_cvt_pk_bf8_f32(s1[8 * s2 + 0], s1[8 * s2 + 1], 0u, false); w1.x = __builtin_amdgcn_cvt_pk_bf8_f32(s1[8 * s2 + 2], s1[8 * s2 + 3], w1.x, true);
                w1.y = __builtin_amdgcn_cvt_pk_bf8_f32(s1[8 * s2 + 4], s1[8 * s2 + 5], 0u, false); w1.y = __builtin_amdgcn_cvt_pk_bf8_f32(s1[8 * s2 + 6], s1[8 * s2 + 7], w1.y, true);
                const unsigned ws_[4] = {w0.x, w0.y, w1.x, w1.y};
#pragma unroll
                for (int q = 0; q < 4; ++q) { const f32x2_t a = __builtin_amdgcn_cvt_pk_f32_bf8(ws_[q], false), c2 = __builtin_amdgcn_cvt_pk_f32_bf8(ws_[q], true); ps += (a.x + a.y) + (c2.x + c2.y); }
                pb[s2] = __builtin_bit_cast(long, w0); pb[2 + s2] = __builtin_bit_cast(long, w1); }
            l_run += ps;
            const LAS unsigned char* vb = lds + buf * (AT_KB + AT_VB) + AT_KB + r32 * AT_VROW + hi * 4;
#pragma unroll
            for (int dp = 0; dp < 4; dp += 2) { long vf[2][4];
#pragma unroll
                for (int d2 = 0; d2 < 2; ++d2)
#pragma unroll
                    for (int ks = 0; ks < 4; ++ks) { const unsigned lo = *(const LAS unsigned*)(vb + (dp + d2) * 32 * AT_VROW + ks * 16), hh = *(const LAS unsigned*)(vb + (dp + d2) * 32 * AT_VROW + ks * 16 + 8);
                        vf[d2][ks] = (long)(((unsigned long long)hh << 32) | lo); }
                __builtin_amdgcn_sched_barrier(0);
#pragma unroll
                for (int ks = 0; ks < 4; ++ks)
#pragma unroll
                    for (int d2 = 0; d2 < 2; ++d2) o[dp + d2] = __builtin_amdgcn_mfma_f32_32x32x16_fp8_bf8(vf[d2][ks], pb[ks], o[dp + d2], 0, 0, 0);
                __builtin_amdgcn_sched_barrier(0); }
        }
        if (t + 1 < NT) AT_STORE(buf ^ 1);
        __syncthreads();
    }
#undef AT_LOAD
#undef AT_STORE
    if (has_next) attn_prefetch(A, nb, nh, nqb, tid, P, true, false);
    const float lt = l_run + __shfl_xor(l_run, 32), inv = 1.0f / lt;
    LAS unsigned char* stg = lds + AT_OST + wid * (32 * 272);
    const float inv8 = inv * (pg8::OB_SC / pg8::K_SC);
#pragma unroll
    for (int d = 0; d < 4; ++d)
#pragma unroll
        for (int g = 0; g < 4; ++g) { unsigned w = __builtin_amdgcn_cvt_pk_fp8_f32(o[d][4 * g] * inv8, o[d][4 * g + 1] * inv8, 0u, false); w = __builtin_amdgcn_cvt_pk_fp8_f32(o[d][4 * g + 2] * inv8, o[d][4 * g + 3] * inv8, w, true);
            *(LAS unsigned*)(stg + r32 * 144 + (32 * d + 8 * g + 4 * hi)) = w; }
    asm volatile("s_waitcnt lgkmcnt(0)" ::: "memory");
    { unsigned char* ob = (unsigned char*)obuf + ((size_t)b * SEQ + q0 + wid * 32 + (lane >> 3)) * 2048 + h * 128 + (lane & 7) * 16;
#pragma unroll
      for (int i4 = 0; i4 < 4; ++i4) { const v4u v = *(const LAS v4u*)(stg + (i4 * 8 + (lane >> 3)) * 144 + (lane & 7) * 16); *(GAS v4u*)(ob + (size_t)i4 * 8 * 2048) = v; } }
}

__device__ __forceinline__ int moe_tables(const Args& A, int layer, LAS unsigned char* lds, int tid) {
    LAS int* tstart = (LAS int*)(lds + TAB_TSTART); LAS unsigned char* tile_e = lds + TAB_TILEE;
    const unsigned* cnt = (const unsigned*)(A.ws + WS_CTL) + CW_CNT + layer * NE * 16;
    LAS int* lcn = (LAS int*)(lds + TAB_LCNT);
    if (tid < NE) lcn[tid] = (int)__hip_atomic_load(cnt + tid * 16, RLX_AGENT);
    __syncthreads();
    if (tid == 0) { int acc = 0; for (int e = 0; e < NE; ++e) { tstart[e] = acc; acc += (lcn[e] + 255) >> 8; } tstart[NE] = acc; }
    __syncthreads();
    if (tid < NE) { const int s = tstart[tid], e2 = tstart[tid + 1]; for (int i = s; i < e2; ++i) tile_e[i] = (unsigned char)tid; }
    __syncthreads();
    return tstart[NE];
}

__device__ __forceinline__ void ln_row(f32x4 (&v)[4], const f32x4 (&g)[4], const f32x4 (&bb)[4]) {
    float s = 0.f;
#pragma unroll
    for (int j = 0; j < 4; ++j) s += (v[j].x + v[j].y) + (v[j].z + v[j].w);
    const float mean = wave_sum(s) * (1.f / D); float s2 = 0.f;
#pragma unroll
    for (int j = 0; j < 4; ++j) { v[j] = v[j] - mean; s2 += (v[j].x * v[j].x + v[j].y * v[j].y) + (v[j].z * v[j].z + v[j].w * v[j].w); }
    const float rstd = 1.f / sqrtf(wave_sum(s2) * (1.f / D) + LN_EPS);
#pragma unroll
    for (int j = 0; j < 4; ++j) v[j] = v[j] * rstd * g[j] + bb[j];
}

#define IN(k) (lo <= (k) && (k) < hi)
#define REPEAT(loc) for (int rep_ = ((layer == REP_LAYER && ((REP_MASK >> (loc)) & 1)) ? 0 : 1); rep_ < 2; ++rep_)
#define OPQ() int tid = tid_of(wave_s); asm volatile("" : "+v"(tid)); const int lane = tid & 63, wave = __builtin_amdgcn_readfirstlane(tid >> 6); (void)lane; (void)wave; OPQW()
#define OPQW() unsigned char* ws = A.ws; asm volatile("" : "+s"(ws)); gu32* ctl = (gu32*)(ws + WS_CTL); bf16* xb = (bf16*)(ws + WS_XB); bf16* tbuf = (bf16*)(ws + WS_TBUF); (void)ctl; (void)xb; (void)tbuf
#define SEAM() do { if (A.single) xcd_barrier(bar); } while (0)

template <int layer> __device__ __forceinline__ void run_layer(const Args& A, LAS unsigned char* lds, const XcdBarrier& bar, const int G, const int bx, const int vcu, const int lo, const int hi, const int wave_s) {
        const int sb = 1 + layer * 16;
        if constexpr (layer < N_A) {
            if (IN(sb + 0)) REPEAT(0) {
                OPQW();
                pg8::Gemm g{(const bf16*)(ws + WS_X8), (const bf16*)(ws + WS_HGWIN) + (size_t)layer * 4096 * 512, T, 4096, 512}; pg8::StaticOrder S; S.init(T, 4096, G, bx);
                pg8::EpiHgIn E{(bf16*)(ws + WS_BIG), (const float*)(ws + WS_LBTAB) + layer * 1024};
                pg8::gemm_phase<pg8::EpiHgIn, pg8::StaticOrder, true, true>(lds + RING_OFF, g, S, E, wave_s); SEAM();
            }
            if (IN(sb + 1)) REPEAT(1) {
                OPQ();
                for (int u = vcu; u < BATCH * HGH; u += G) hg_chunk_unit(A, layer, u, lds, tid);
                SEAM();
            }
        } else {
            const int j = layer - N_A;
            if constexpr (layer == N_A) {
                if (IN(sb + 0)) REPEAT(0) {
                OPQW();
                    pg8::Gemm g{xb, (const bf16*)(ws + WS_KVA), T, 256, 1024}; pg8::StaticOrder S; S.init(T, 256, G, bx);
                    pg8::EpiKva E{(bf16*)(ws + WS_CKV), (const float*)(ws + WS_ROPE)};
                    pg8::gemm_phase<pg8::EpiKva, pg8::StaticOrder, true, true>(lds + RING_OFF, g, S, E, wave_s); SEAM();
                }
                if (IN(sb + 1)) REPEAT(1) {
                OPQ();
                    bf16* ckv = (bf16*)(ws + WS_CKV); bf16* ckvT = (bf16*)(ws + WS_CKVT); const int sub = lane & 15; const f32x4 g0 = *(const f32x4*)(A.kv_norm + sub * 8), g1 = *(const f32x4*)(A.kv_norm + sub * 8 + 4);
                    LAS unsigned short* tl = (LAS unsigned short*)lds;
                    for (int c0 = vcu * 256; c0 < T; c0 += G * 256) {
                        for (int rr = tid >> 4; rr < 256; rr += NTHR >> 4) { GAS v4u* p = (GAS v4u*)(ckv + (size_t)(c0 + rr) * 256 + sub * 8); const v4u w = *p;
                            float f[8] = {bflo(w.x), bfhi(w.x), bflo(w.y), bfhi(w.y), bflo(w.z), bfhi(w.z), bflo(w.w), bfhi(w.w)}; float ss = 0.f;
#pragma unroll
                            for (int i = 0; i < 8; ++i) ss += f[i] * f[i];
                            ss += __shfl_xor(ss, 1); ss += __shfl_xor(ss, 2); ss += __shfl_xor(ss, 4); ss += __shfl_xor(ss, 8);
                            const float rs = 1.0f / sqrtf(ss * (1.0f / 128.0f) + RMS_EPS);
                            const v4u o = {cvtpk(f[0] * rs * g0[0], f[1] * rs * g0[1]), cvtpk(f[2] * rs * g0[2], f[3] * rs * g0[3]), cvtpk(f[4] * rs * g1[0], f[5] * rs * g1[1]), cvtpk(f[6] * rs * g1[2], f[7] * rs * g1[3])};
                            *p = o; const unsigned ow[4] = {o.x, o.y, o.z, o.w};
                            {   unsigned char* k8 = ws + WS_CK8 + (size_t)(c0 + rr) * 192; constexpr float ks = pg8::K_SC; pg8::u32x2 w8;
                                w8.x = __builtin_amdgcn_cvt_pk_fp8_f32(f[0] * rs * g0[0] * ks, f[1] * rs * g0[1] * ks, 0u, false); w8.x = __builtin_amdgcn_cvt_pk_fp8_f32(f[2] * rs * g0[2] * ks, f[3] * rs * g0[3] * ks, w8.x, true);
                                w8.y = __builtin_amdgcn_cvt_pk_fp8_f32(f[4] * rs * g1[0] * ks, f[5] * rs * g1[1] * ks, 0u, false); w8.y = __builtin_amdgcn_cvt_pk_fp8_f32(f[6] * rs * g1[2] * ks, f[7] * rs * g1[3] * ks, w8.y, true);
                                *(GAS pg8::u32x2*)(k8 + sub * 8) = w8;
                                const pg8::u32x2 rp = *(const GAS pg8::u32x2*)(ckv + (size_t)(c0 + rr) * 256 + 128 + sub * 4);
                                unsigned r8 = __builtin_amdgcn_cvt_pk_fp8_f32(bflo(rp.x) * ks, bfhi(rp.x) * ks, 0u, false); r8 = __builtin_amdgcn_cvt_pk_fp8_f32(bflo(rp.y) * ks, bfhi(rp.y) * ks, r8, true);
                                *(GAS unsigned*)(k8 + 128 + sub * 4) = r8; }
#pragma unroll
                            for (int i = 0; i < 4; ++i) { tl[(sub * 8 + 2 * i) * 264 + rr] = (unsigned short)(ow[i] & 0xffffu); tl[(sub * 8 + 2 * i + 1) * 264 + rr] = (unsigned short)(ow[i] >> 16); } }
                        __syncthreads();
                        for (int q = tid; q < 128 * 32; q += NTHR) { const int d = q >> 5, ch = q & 31; const v4u w = *(const LAS v4u*)(tl + d * 264 + ch * 8); constexpr float ks = pg8::K_SC; pg8::u32x2 w8;
                            w8.x = __builtin_amdgcn_cvt_pk_fp8_f32(bflo(w.x) * ks, bfhi(w.x) * ks, 0u, false); w8.x = __builtin_amdgcn_cvt_pk_fp8_f32(bflo(w.y) * ks, bfhi(w.y) * ks, w8.x, true);
                            w8.y = __builtin_amdgcn_cvt_pk_fp8_f32(bflo(w.z) * ks, bfhi(w.z) * ks, 0u, false); w8.y = __builtin_amdgcn_cvt_pk_fp8_f32(bflo(w.w) * ks, bfhi(w.w) * ks, w8.y, true);
                            *(GAS pg8::u32x2*)(ws + WS_CVT8 + (size_t)d * T + c0 + ch * 8) = w8; (void)ckvT; }
                        __syncthreads();
                    }
                    SEAM();
                }
            }
            if (IN(sb + 4)) REPEAT(4) {
                OPQW();
                pg8::Gemm g{xb, (const bf16*)(ws + WS_DQ) + (size_t)j * 256 * 1024, T, 256, 1024}; pg8::StaticOrder S; S.init(T, 256, G, bx); pg8::EpiPlain E{(bf16*)(ws + WS_CQ), 256, 1.0f};
                pg8::gemm_phase<pg8::EpiPlain, pg8::StaticOrder, true, true>(lds + RING_OFF, g, S, E, wave_s); SEAM();
            }
            if (IN(sb + 5)) REPEAT(5) {
                OPQ();
                bf16* cq = (bf16*)(ws + WS_CQ); const int sub = lane & 31; const f32x4 g0 = *(const f32x4*)(A.mla_q_norm + j * 256 + sub * 8), g1 = *(const f32x4*)(A.mla_q_norm + j * 256 + sub * 8 + 4);
                for (int r = (vcu * NTHR + tid) >> 5; r < T; r += (G * NTHR) >> 5) { GAS v4u* p = (GAS v4u*)(cq + (size_t)r * 256 + sub * 8); const v4u w = *p;
                    float f[8] = {bflo(w.x), bfhi(w.x), bflo(w.y), bfhi(w.y), bflo(w.z), bfhi(w.z), bflo(w.w), bfhi(w.w)}; float ss = 0.f;
#pragma unroll
                    for (int i = 0; i < 8; ++i) ss += f[i] * f[i];
                    ss += __shfl_xor(ss, 1); ss += __shfl_xor(ss, 2); ss += __shfl_xor(ss, 4); ss += __shfl_xor(ss, 8); ss += __shfl_xor(ss, 16);
                    const float rs = 1.0f / sqrtf(ss * (1.0f / 256.0f) + RMS_EPS);
                    *p = (v4u){cvtpk(f[0] * rs * g0[0], f[1] * rs * g0[1]), cvtpk(f[2] * rs * g0[2], f[3] * rs * g0[3]), cvtpk(f[4] * rs * g1[0], f[5] * rs * g1[1]), cvtpk(f[6] * rs * g1[2], f[7] * rs * g1[3])}; }
                SEAM();
            }
            if (IN(sb + 6)) REPEAT(6) {
                OPQW();
                pg8::Gemm g{(const bf16*)(ws + WS_CQ), (const bf16*)(ws + WS_UQ) + (size_t)j * 3072 * 256, T, 3072, 256}; pg8::StaticOrder S; S.init(T, 3072, G, bx);
                pg8::EpiUq E{(bf16*)(ws + WS_BIG), (const float*)(ws + WS_ROPE), QSCALE};
                pg8::gemm_phase<pg8::EpiUq, pg8::StaticOrder, true, true>(lds + RING_OFF, g, S, E, wave_s); SEAM();
            }
            if (IN(sb + 7)) REPEAT(7) {
                OPQ();
                if (vcu < BATCH * MH) { AttnPre pre; attn_prefetch(A, vcu / MH, vcu % MH, 7, tid, pre, true, false);
                    for (int u = vcu; u < BATCH * MH; u += G) { const int b = u / MH, h = u % MH;
                        for (int qb = 7; qb >= 0; --qb) { const bool nx = qb > 0 || u + G < BATCH * MH; const int nu = qb > 0 ? u : u + G; attn_unit(A, b, h, qb, lds, tid, pre, nx, nu / MH, nu % MH, qb > 0 ? qb - 1 : 7, false); } } }
                SEAM();
            }
        }
        if (IN(sb + 8)) REPEAT(8) {
                OPQW();
            pg8::StaticOrder S; S.init(T, 1024, G, bx);
            if constexpr (layer < N_A) { pg8::Gemm g{(const bf16*)(ws + WS_ABUF), (const bf16*)(ws + WS_HGWO) + (size_t)layer * 1024 * 512, T, 1024, 512};
                pg8::EpiResT<true> E{xb, tbuf, DN_ALPHA, 1.0f / (pg8::HWO_SC * pg8::OG_SC)};
                pg8::gemm_phase<pg8::EpiResT<true>, pg8::StaticOrder, true, true>(lds + RING_OFF, g, S, E, wave_s); }
            else { pg8::Gemm g{(const bf16*)(ws + WS_ABUF), (const bf16*)(ws + WS_MWO) + (size_t)(layer - N_A) * 1024 * 1024, T, 1024, 1024};
                pg8::EpiResT<true> E{xb, tbuf, DN_ALPHA, 1.0f / (pg8::MWO_SC * pg8::OB_SC)};
                pg8::gemm_phase<pg8::EpiResT<true>, pg8::StaticOrder, true, true>(lds + RING_OFF, g, S, E, wave_s); }
            SEAM();
        }
        if (IN(sb + 9)) REPEAT(9) {
                OPQ();
            LAS unsigned char* Whi = lds + R1_WHI; LAS unsigned char* Wlo = lds + R1_WLO; LAS float* stat = (LAS float*)(lds + R1_STAT); LAS float* S1 = (LAS float*)(lds + R1_S12); LAS float* S2 = S1 + 32; LAS float* red = (LAS float*)(lds + R1_RED);
            LAS int* lcnt = (LAS int*)(lds + TAB_LCNT); LAS int* lbase = (LAS int*)(lds + TAB_LBASE); LAS int* a_e = (LAS int*)(lds + TAB_AE); LAS int* a_rank = (LAS int*)(lds + TAB_ARANK); LAS float* a_g = (LAS float*)(lds + TAB_AG);
            {
                const unsigned char* img = ws + WS_RIMG + (size_t)layer * RIMG_STRIDE; (void)red;
#pragma unroll
                for (int i = 0; i < 16; ++i) { const int idx = wave * 16 + i, row = idx >> 1, half = idx & 1;
                    __builtin_amdgcn_global_load_lds((const unsigned*)(img + (size_t)row * 2048 + half * 1024 + lane * 16), (LAS unsigned*)(lds + (row < 32 ? R1_WHI + row * R1_WROW : R1_WLO + (row - 32) * R1_WROW) + half * 1024), 16, 0, 0); }
                if (tid < 64) S1[tid] = *(const GAS float*)(img + 131072 + tid * 4);
                if (tid < NE) lcnt[tid] = 0;
                asm volatile("s_waitcnt vmcnt(0)" ::: "memory");
                __syncthreads(); }
            f32x4 gv[4], bv[4];
#pragma unroll
            for (int jj = 0; jj < 4; ++jj) { gv[jj] = *(const f32x4*)(A.ln_g + (size_t)(layer * 2 + 0) * D + 4 * lane + 256 * jj); bv[jj] = *(const f32x4*)(A.ln_b + (size_t)(layer * 2 + 0) * D + 4 * lane + 256 * jj); }
            const int chunk = T / G, wbase = vcu * chunk;
            for (int w0 = wave * 32; w0 < chunk; w0 += NWAVES * 32) {
                unsigned long long rw_[4][4], rn_[4][4];
#pragma unroll
                for (int tt = 0; tt < 4; ++tt)
#pragma unroll
                    for (int jj = 0; jj < 4; ++jj) rw_[tt][jj] = *(const GAS unsigned long long*)(tbuf + (size_t)(wbase + w0 + tt) * D + 4 * lane + 256 * jj);
                for (int p = 0; p < 32; p += 4) {
                    if (p + 4 < 32) {
#pragma unroll
                        for (int tt = 0; tt < 4; ++tt)
#pragma unroll
                            for (int jj = 0; jj < 4; ++jj) rn_[tt][jj] = *(const GAS unsigned long long*)(tbuf + (size_t)(wbase + w0 + p + 4 + tt) * D + 4 * lane + 256 * jj); }
#pragma unroll
                    for (int tt = 0; tt < 4; ++tt) { const size_t m = (size_t)(wbase + w0 + p + tt);
                        f32x4 xr[4];
#pragma unroll
                        for (int jj = 0; jj < 4; ++jj) { const unsigned wl = (unsigned)rw_[tt][jj], wh = (unsigned)(rw_[tt][jj] >> 32); xr[jj] = (f32x4){bflo(wl), bfhi(wl), bflo(wh), bfhi(wh)}; }
                        float s = 0.f;
#pragma unroll
                        for (int jj = 0; jj < 4; ++jj) s += (xr[jj].x + xr[jj].y) + (xr[jj].z + xr[jj].w);
                        const float mean = wave_sum(s) * (1.f / D); float s2 = 0.f;
#pragma unroll
                        for (int jj = 0; jj < 4; ++jj) { const f32x4 d = xr[jj] - mean; s2 += (d.x * d.x + d.y * d.y) + (d.z * d.z + d.w * d.w); }
                        const float rstd = 1.f / sqrtf(wave_sum(s2) * (1.f / D) + LN_EPS);
                        if (lane == 0) { stat[(w0 + p + tt) * 2] = mean; stat[(w0 + p + tt) * 2 + 1] = rstd; *(GAS f32x2_t*)(ws + WS_STATS + m * 8) = (f32x2_t){mean, rstd}; }
#pragma unroll
                        for (int jj = 0; jj < 4; ++jj) { const f32x4 y = (xr[jj] - mean) * rstd * gv[jj] + bv[jj];
                            *(GAS unsigned*)(ws + WS_X8 + m * D + 4 * lane + 256 * jj) = __builtin_amdgcn_cvt_pk_fp8_f32(y.z, y.w, __builtin_amdgcn_cvt_pk_fp8_f32(y.x, y.y, 0u, false), true); } }
#pragma unroll
                    for (int tt = 0; tt < 4; ++tt)
#pragma unroll
                        for (int jj = 0; jj < 4; ++jj) rw_[tt][jj] = rn_[tt][jj];
                }
                const int r32 = lane & 31, hh = lane >> 5;
                f32x16 acc;
#pragma unroll
                for (int i = 0; i < 16; ++i) acc[i] = 0.f;
                {   const bf16* tp = tbuf + (size_t)(wbase + w0 + r32) * D + 8 * hh; const LAS unsigned char* wh = Whi + r32 * R1_WROW + hh * 16; const LAS unsigned char* wl = Wlo + r32 * R1_WROW + hh * 16;
#pragma unroll 8
                    for (int s_ = 0; s_ < 64; ++s_) { const bf16x8 bt = *(const GAS bf16x8*)(tp + 16 * s_);
                        acc = __builtin_amdgcn_mfma_f32_32x32x16_bf16(*(const LAS bf16x8*)(wh + 32 * s_), bt, acc, 0, 0, 0);
                        acc = __builtin_amdgcn_mfma_f32_32x32x16_bf16(*(const LAS bf16x8*)(wl + 32 * s_), bt, acc, 0, 0, 0); } }
                asm volatile("s_waitcnt lgkmcnt(0)" ::: "memory");
                const float mu = stat[(w0 + r32) * 2], rs = stat[(w0 + r32) * 2 + 1];
                float lv[16];
#pragma unroll
                for (int g4 = 0; g4 < 4; ++g4) { const f32x4 a1 = *(const LAS f32x4*)(S1 + 8 * g4 + 4 * hh), a2 = *(const LAS f32x4*)(S2 + 8 * g4 + 4 * hh);
#pragma unroll
                    for (int q = 0; q < 4; ++q) lv[4 * g4 + q] = rs * (acc[4 * g4 + q] - mu * a1[q]) + a2[q]; }
                float cv[8]; int ci[8];
#pragma unroll
                for (int k = 0; k < 4; ++k) { float bvv = -__builtin_inff(); int bi = 64;
#pragma unroll
                    for (int i = 0; i < 16; ++i) { const int ei = crow(i, hh); const bool tk = lv[i] > bvv || (lv[i] == bvv && ei < bi); bvv = tk ? lv[i] : bvv; bi = tk ? ei : bi; }
#pragma unroll
                    for (int i = 0; i < 16; ++i) if (crow(i, hh) == bi) lv[i] = -__builtin_inff();
                    cv[k] = bvv; ci[k] = bi; }
#pragma unroll
                for (int k = 0; k < 4; ++k) { cv[4 + k] = __shfl_xor(cv[k], 32); ci[4 + k] = __shfl_xor(ci[k], 32); }
                float tv[4]; int te[4];
#pragma unroll
                for (int k = 0; k < 4; ++k) { float bvv = -__builtin_inff(); int bi = 64;
#pragma unroll
                    for (int i = 0; i < 8; ++i) { const bool tk = cv[i] > bvv || (cv[i] == bvv && ci[i] < bi); bvv = tk ? cv[i] : bvv; bi = tk ? ci[i] : bi; }
#pragma unroll
                    for (int i = 0; i < 8; ++i) if (ci[i] == bi) cv[i] = -__builtin_inff();
                    tv[k] = bvv; te[k] = bi; }
                const float e1 = __expf(tv[1] - tv[0]), e2 = __expf(tv[2] - tv[0]), e3 = __expf(tv[3] - tv[0]); const float inv = 1.0f / (1.0f + e1 + e2 + e3);
                if (hh == 0) { const float gk[4] = {inv, e1 * inv, e2 * inv, e3 * inv};
#pragma unroll
                    for (int k = 0; k < 4; ++k) { const int la = (w0 + r32) * 4 + k; a_g[la] = gk[k]; a_e[la] = te[k]; a_rank[la] = __hip_atomic_fetch_add(&lcnt[te[k]], 1, __ATOMIC_RELAXED, __HIP_MEMORY_SCOPE_WORKGROUP); } }
            }
            __syncthreads();
            if (tid < NE) lbase[tid] = (rep_ == 1) ? (int)__hip_atomic_fetch_add((unsigned*)(ctl + CW_CNT + layer * NE * 16 + tid * 16), (unsigned)lcnt[tid], RLX_AGENT) : 0;
            __syncthreads();
            if (rep_ == 1) for (int la = tid; la < chunk * 4; la += NTHR) { const int e = a_e[la]; const size_t ix = (size_t)e * ECAP + lbase[e] + a_rank[la]; const int pos = lbase[e] + a_rank[la];
                ((GAS int*)(ws + WS_RSLOT))[ix] = wbase * 4 + la; ((GAS int*)(ws + WS_ASG))[(size_t)wbase * 4 + la] = (e << 24) | pos; ((GAS float*)(ws + WS_AGATE))[(size_t)wbase * 4 + la] = a_g[la]; }
            __syncthreads();
            SEAM();
        }
        if (IN(sb + 11)) REPEAT(11) {
                OPQ();
            const int nM = moe_tables(A, layer, lds, tid);
            pg8::Gemm g{(const bf16*)(ws + WS_X8), (const bf16*)(ws + WS_W1) + (size_t)layer * NE * 2048 * 512, nM * 256, 2048, 512};
            pg8::MoeOrder S; S.init(nM * 256, 2048, G, bx, MOE_WGM); S.tile_e = lds + TAB_TILEE; S.tstart = (const LAS int*)(lds + TAB_TSTART); S.cnt = (const LAS int*)(lds + TAB_LCNT); S.cap = ECAP;
            pg8::EpiMoe1 E{ws + WS_ABUF, A.moe_b1 + (size_t)layer * NE * 2048};
            pg8::gemm_phase<pg8::EpiMoe1, pg8::MoeOrder, true, true, true>(lds + RING_OFF, g, S, E, wave_s, (const int*)(ws + WS_RSLOT), lds + GP_OFF); SEAM();
        }
        if (IN(sb + 12)) REPEAT(12) {
                OPQ();
            const int nM = moe_tables(A, layer, lds, tid);
            pg8::Gemm g{(const bf16*)(ws + WS_ABUF), (const bf16*)(ws + WS_W2) + (size_t)layer * NE * 1024 * 512, nM * 256, 1024, 512};
            pg8::MoeOrder S; S.init(nM * 256, 1024, G, bx, MOE_WGM); S.tile_e = lds + TAB_TILEE; S.tstart = (const LAS int*)(lds + TAB_TSTART); S.cnt = (const LAS int*)(lds + TAB_LCNT); S.cap = ECAP;
            S.rev = 1;
            if (rep_ == 0) S.pmmask = 31;
            pg8::EpiMoe2 E{(bf16*)(ws + WS_BIG), A.moe_b2 + (size_t)layer * NE * 1024};
            pg8::gemm_phase<pg8::EpiMoe2, pg8::MoeOrder, true, true, false, true>(lds + RING_OFF, g, S, E, wave_s, nullptr, lds + GP_OFF); SEAM();
        }
        if (IN(sb + 13)) REPEAT(13) {
                OPQ();
            const bf16* ybuf = (const bf16*)(ws + WS_BIG);
            moe_tables(A, layer, lds, tid); const LAS int* tstart = (const LAS int*)(lds + TAB_TSTART);
            f32x4 gv[4], bv[4];
#pragma unroll
            for (int jj = 0; jj < 4; ++jj) { gv[jj] = *(const f32x4*)(A.ln_g + (size_t)(layer * 2 + 1) * D + 4 * lane + 256 * jj); bv[jj] = *(const f32x4*)(A.ln_b + (size_t)(layer * 2 + 1) * D + 4 * lane + 256 * jj); }
            f32x4 ga[4], ba[4];
#pragma unroll
            for (int jj = 0; jj < 4; ++jj) { ga[jj] = *(const f32x4*)(A.ln_g + (size_t)(layer * 2 + 0) * D + 4 * lane + 256 * jj) * DN_ALPHA; ba[jj] = *(const f32x4*)(A.ln_b + (size_t)(layer * 2 + 0) * D + 4 * lane + 256 * jj) * DN_ALPHA; }
            v4u acn = *(const GAS v4u*)((const int*)(ws + WS_ASG) + (size_t)(vcu * NWAVES + wave) * 4); f32x4 agn = *(const GAS f32x4*)((const float*)(ws + WS_AGATE) + (size_t)(vcu * NWAVES + wave) * 4);
            for (int m = vcu * NWAVES + wave; m < T; m += G * NWAVES) {
                f32x4 v[4];
                const v4u ac = acn; const f32x4 ag = agn;
                { const int mn = m + G * NWAVES < T ? m + G * NWAVES : m;
                  acn = *(const GAS v4u*)((const int*)(ws + WS_ASG) + (size_t)mn * 4); agn = *(const GAS f32x4*)((const float*)(ws + WS_AGATE) + (size_t)mn * 4); }
                const f32x2_t st1 = *(const GAS f32x2_t*)(ws + WS_STATS + (size_t)m * 8);
                const unsigned acs[4] = {ac.x, ac.y, ac.z, ac.w}; size_t yrow[4];
#pragma unroll
                for (int k = 0; k < 4; ++k) yrow[k] = (size_t)(tstart[acs[k] >> 24] * 256 + (int)(acs[k] & 0xffffffu)) * D;
#pragma unroll
                for (int jj = 0; jj < 4; ++jj) { { const unsigned long long w = *(const GAS unsigned long long*)(tbuf + (size_t)m * D + 4 * lane + 256 * jj); const unsigned wl = (unsigned)w, wh = (unsigned)(w >> 32); v[jj] = ((f32x4){bflo(wl), bfhi(wl), bflo(wh), bfhi(wh)} - st1.x) * st1.y * ga[jj] + ba[jj]; }
#pragma unroll
                    for (int k = 0; k < 4; ++k) { const unsigned w = *(const GAS unsigned*)((const unsigned char*)ybuf + yrow[k] + 4 * lane + 256 * jj); const float gk = ag[k];
                        const f32x2_t lo2 = __builtin_amdgcn_cvt_pk_f32_fp8(w, false), hi2 = __builtin_amdgcn_cvt_pk_f32_fp8(w, true);
                        v[jj].x += gk * lo2.x; v[jj].y += gk * lo2.y; v[jj].z += gk * hi2.x; v[jj].w += gk * hi2.y; } }
                ln_row(v, gv, bv);
#pragma unroll
                for (int jj = 0; jj < 4; ++jj) { if (layer + 1 == DEPTH && rep_ == 1) *(GAS f32x4*)(A.out + (size_t)m * D + 4 * lane + 256 * jj) = v[jj];
                    if (layer + 1 < DEPTH && rep_ == 1)
                    *(GAS unsigned long long*)(xb + (size_t)m * D + 4 * lane + 256 * jj) = (unsigned long long)cvtpk(v[jj].x, v[jj].y) | ((unsigned long long)cvtpk(v[jj].z, v[jj].w) << 32);
                    if constexpr (layer + 1 < N_A) *(GAS unsigned*)(ws + WS_X8 + (size_t)m * D + 4 * lane + 256 * jj) = __builtin_amdgcn_cvt_pk_fp8_f32(v[jj].z, v[jj].w, __builtin_amdgcn_cvt_pk_fp8_f32(v[jj].x, v[jj].y, 0u, false), true); }
            }
            if (layer + 1 < DEPTH) SEAM();
        }
}

__global__ void __launch_bounds__(NTHR, 2) yoco_fwd(Args A) {
    extern __shared__ __attribute__((aligned(16))) unsigned char lds_raw[];
    LAS unsigned char* lds = (LAS unsigned char*)lds_raw;
    volatile LAS unsigned* MISC = (volatile LAS unsigned*)(lds + MISC_OFF);
    const int wave_s = __builtin_amdgcn_readfirstlane((int)threadIdx.x >> 6); const int tid0 = tid_of(wave_s);
    const int G = gridDim.x; const int bx = blockIdx.x; const int vcu = (G % 8 == 0) ? (bx % 8) * (G / 8) + bx / 8 : bx;
    gu32* ctl0 = (gu32*)(A.ws + WS_CTL);
    for (int u = tid0; u < (LDS_BYTES - LDSCTL_OFF) / 4; u += NTHR) ((LAS unsigned*)(lds + LDSCTL_OFF))[u] = 0u;
    __syncthreads();
    XcdBarrier bar; bar.wave_s = wave_s; bar.bar = (unsigned*)(ctl0 + CW_BAR); bar.x = 0; bar.st = nullptr;
    if (A.single) bar = xcd_barrier_post((unsigned*)(ctl0 + CW_BAR), MISC + 8, wave_s);
    const int lo = A.st_lo, hi = A.st_hi;

    if (IN(0)) for (int rep_ = (REP_LAYER == 9) ? 0 : 1; rep_ < 2; ++rep_) { OPQ(); p0_prologue(A, lds, vcu, G, wave, lane, tid); SEAM(); }

    run_layer<0>(A, lds, bar, G, bx, vcu, lo, hi, wave_s);
    run_layer<1>(A, lds, bar, G, bx, vcu, lo, hi, wave_s);
    run_layer<2>(A, lds, bar, G, bx, vcu, lo, hi, wave_s);
    run_layer<3>(A, lds, bar, G, bx, vcu, lo, hi, wave_s);
#undef IN
#undef SEAM
}

extern "C" void kernel_launch(void* const* d_in, const int* in_sizes, int n_in, void* d_out, int out_size, void* d_ws, size_t ws_size, hipStream_t stream) {
    static int grid = 0;
    if (grid == 0) {
        if (n_in != 21 || in_sizes[0] != T * D || out_size != T * D || ws_size < WS_END) { fprintf(stderr, "kernel_launch: unexpected shapes (n_in %d, in0 %d, out %d, ws %zu)\n", n_in, n_in > 0 ? in_sizes[0] : -1, out_size, ws_size); grid = -1; return; }
        int dev = 0, cus = 0, per_cu = 0;
        if (hipGetDevice(&dev) != hipSuccess || hipDeviceGetAttribute(&cus, hipDeviceAttributeMultiprocessorCount, dev) != hipSuccess) { grid = -1; return; }
        if (hipFuncSetAttribute((const void*)yoco_fwd, hipFuncAttributeMaxDynamicSharedMemorySize, LDS_BYTES) != hipSuccess) { fprintf(stderr, "kernel_launch: hipFuncSetAttribute failed\n"); grid = -1; return; }
        if (hipOccupancyMaxActiveBlocksPerMultiprocessor(&per_cu, (const void*)yoco_fwd, NTHR, LDS_BYTES) != hipSuccess || per_cu < 1) fprintf(stderr, "kernel_launch: occupancy query reports %d\n", per_cu);
        (void)hipGetLastError();
        grid = cus;
        if (grid != 256) { fprintf(stderr, "kernel_launch: built for 256 CUs, device has %d\n", cus); grid = -1; return; }
    }
    if (grid < 0) return;
    if (hipMemsetAsync((char*)d_ws + WS_CTL, 0, CTL_ZERO_BYTES, stream) != hipSuccess) return;
    Args a{};
    a.x = (const float*)d_in[0]; a.pos = (const int*)d_in[1]; a.ln_g = (const float*)d_in[2]; a.ln_b = (const float*)d_in[3]; a.hg_w_in = (const float*)d_in[4]; a.hg_lb = (const float*)d_in[5];
    a.hg_gnorm = (const float*)d_in[6]; a.hg_w_o = (const float*)d_in[7]; a.mla_w_dq = (const float*)d_in[8]; a.mla_q_norm = (const float*)d_in[9]; a.mla_w_uq = (const float*)d_in[10]; a.mla_w_o = (const float*)d_in[11];
    a.kv_w_a = (const float*)d_in[12]; a.kv_norm = (const float*)d_in[13]; a.kv_w_b = (const float*)d_in[14]; a.router_w = (const float*)d_in[15]; a.router_b = (const float*)d_in[16];
    a.moe_w1 = (const float*)d_in[17]; a.moe_b1 = (const float*)d_in[18]; a.moe_w2 = (const float*)d_in[19]; a.moe_b2 = (const float*)d_in[20];
    a.out = (float*)d_out; a.ws = (unsigned char*)d_ws; a.pad = 0;
#if MK_SINGLE
    a.st_lo = 0; a.st_hi = 1 << 20; a.single = 1;
    hipLaunchKernelGGL(yoco_fwd, dim3(grid), dim3(NTHR), LDS_BYTES, stream, a);
#else
    a.single = 0;
    for (int st = 0; st < 1 + DEPTH * 16; ++st) {
        if (st > 0) { const int layer = (st - 1) / 16, loc = (st - 1) % 16; if (loc > 13 || loc == 10) continue;
            if (layer < N_A) { if (loc >= 2 && loc <= 7) continue; }
            else { if (loc == 2 || loc == 3 || (layer != N_A && loc <= 1)) continue; } }
        a.st_lo = st; a.st_hi = st + 1;
        hipLaunchKernelGGL(yoco_fwd, dim3(grid), dim3(NTHR), LDS_BYTES, stream, a);
    }
#endif
}
```
